# Optimizing an MI355X kernel written in HIP

```python
import math
import jax, jax.numpy as jnp
from jax import lax
import numpy as np

D_MODEL = 1024
BATCH = 16
SEQ = 2048
DEPTH = 4

N_A_LAYERS = DEPTH // 2
N_B_LAYERS = DEPTH - N_A_LAYERS
LRU_WIDTH = D_MODEL
LRU_BLOCKS = 8
LRU_BW = LRU_WIDTH // LRU_BLOCKS
CONV_WIDTH = 4
LRU_C = 8.0
N_HEADS = 16
HEAD_DIM = D_MODEL // N_HEADS
N_KV = 4
HPG = N_HEADS // N_KV
ROT_DIM = HEAD_DIM // 4
ROPE_THETA = 500000.0
CMP_BLOCK = 32
CMP_STRIDE = 16
CMP_HIDDEN = 4 * HEAD_DIM
SEL_BLOCK = 64
N_SEL = 8
WINDOW = 256
WIN_QBLOCK = 128
SEL_QCHUNK = 32
D_FF = 2816
N_EXPERTS = 8
TOP_K = 2
MOE_D_FF = 3584
DN_ALPHA = (2.0 * DEPTH) ** 0.25
DN_BETA = (8.0 * DEPTH) ** -0.25
LN_EPS = 1e-5
NEG = -1e30
BIG = 1e30
F32 = jnp.float32

kernel_name = 'hybrid_rglru_nsa_yoco_moe_deepnorm'


def layer_norm(x, g, b):
    xf = x.astype(F32)
    mu = jnp.mean(xf, -1, keepdims=True)
    var = jnp.mean(jnp.square(xf - mu), -1, keepdims=True)
    return ((xf - mu) * lax.rsqrt(var + LN_EPS) * g + b).astype(x.dtype)


def post_norm(x, y, g, b):
    return layer_norm(DN_ALPHA * x + y, g, b)


def partial_rope(x, pos):
    half = ROT_DIM // 2
    inv = ROPE_THETA ** (-jnp.arange(half, dtype=F32) / half)
    ang = pos.astype(F32)[:, None] * inv[None]
    shape = (1, x.shape[1]) + (1,) * (x.ndim - 3) + (half,)
    cos = jnp.cos(ang).reshape(shape)
    sin = jnp.sin(ang).reshape(shape)
    xr = x[..., :ROT_DIM].astype(F32)
    x1, x2 = xr[..., :half], xr[..., half:]
    rot = jnp.concatenate([x1 * cos - x2 * sin, x2 * cos + x1 * sin], -1).astype(x.dtype)
    return jnp.concatenate([rot, x[..., ROT_DIM:]], -1)


def causal_conv(x, w, b):
    S = x.shape[1]
    xp = jnp.pad(x, ((0, 0), (CONV_WIDTH - 1, 0), (0, 0)))
    y = b + w[0] * xp[:, 0:S]
    for k in range(1, CONV_WIDTH):
        y = y + w[k] * xp[:, k:k + S]
    return y


def recurrent_block(x, w_in, conv_w, conv_b, w_a, b_a, w_i, b_i, lam, w_out):
    B_, S, _ = x.shape
    u = x @ w_in
    gate = jax.nn.gelu(u[..., :LRU_WIDTH])
    xr = causal_conv(u[..., LRU_WIDTH:], conv_w, conv_b)
    xb = xr.reshape(B_, S, LRU_BLOCKS, LRU_BW)
    r = jax.nn.sigmoid(jnp.einsum('bsnc,ncd->bsnd', xb, w_a) + b_a).reshape(B_, S, LRU_WIDTH)
    i = jax.nn.sigmoid(jnp.einsum('bsnc,ncd->bsnd', xb, w_i) + b_i).reshape(B_, S, LRU_WIDTH)
    log_a = (-LRU_C * r.astype(F32)) * jax.nn.softplus(-lam.astype(F32))
    a = jnp.exp(log_a)
    b_t = jnp.sqrt(-jnp.expm1(2.0 * log_a)) * (i * xr).astype(F32)

    def combine(lhs, rhs):
        a1, h1 = lhs
        a2, h2 = rhs
        return a1 * a2, a2 * h1 + h2

    _, h = lax.associative_scan(combine, (a, b_t), axis=1)
    return (h.astype(x.dtype) * gate) @ w_out


def swiglu(x, w_gu, w_down):
    g, u = jnp.split(x @ w_gu, 2, axis=-1)
    return (jax.nn.silu(g) * u) @ w_down


def moe_swiglu(x, w_router, w_gu, w_down):
    logits = (x @ w_router).astype(F32)
    top_v, top_i = lax.top_k(logits, TOP_K)
    top_w = jax.nn.softmax(top_v, -1)
    gates = jnp.sum(jax.nn.one_hot(top_i, N_EXPERTS, dtype=F32) * top_w[..., None], -2)
    out = jnp.zeros_like(x)
    for e in range(N_EXPERTS):
        out = out + gates[..., e:e + 1].astype(x.dtype) * swiglu(x, w_gu[e], w_down[e])
    return out


def nsa_shared_kv(h, w_kv, cmp_pos, cmp_w1, cmp_w2):
    B_, S, _ = h.shape
    kv = (h @ w_kv).reshape(B_, S, 6, N_KV, HEAD_DIM)
    pos = jnp.arange(S)
    k_slc = partial_rope(kv[:, :, 2], pos)
    v_slc = kv[:, :, 3]
    k_win = partial_rope(kv[:, :, 4], pos)
    v_win = kv[:, :, 5]
    nc = (S - CMP_BLOCK) // CMP_STRIDE + 1
    idx = jnp.arange(nc)[:, None] * CMP_STRIDE + jnp.arange(CMP_BLOCK)[None]

    def compress(t, pe, w1, w2):
        blk = t[:, idx] + pe[None, None, :, None, :]
        blk = blk.transpose(0, 1, 3, 2, 4).reshape(B_, nc, N_KV, CMP_BLOCK * HEAD_DIM)
        return jax.nn.gelu(blk @ w1) @ w2

    k_cmp = compress(kv[:, :, 0], cmp_pos[0], cmp_w1[0], cmp_w2[0])
    v_cmp = compress(kv[:, :, 1], cmp_pos[1], cmp_w1[1], cmp_w2[1])
    return k_cmp, v_cmp, k_slc, v_slc, k_win, v_win


def cmp_branch(q, k_cmp, v_cmp, pos):
    nc = k_cmp.shape[1]
    s = jnp.einsum('bsghd,bcgd->bghsc', q, k_cmp).astype(F32)
    blk_end = jnp.arange(nc) * CMP_STRIDE + CMP_BLOCK - 1
    valid = blk_end[None, :] <= pos[:, None]
    p = jax.nn.softmax(jnp.where(valid, s, NEG), -1) * jnp.any(valid, -1)[:, None].astype(F32)
    o = jnp.einsum('bghsc,bcgd->bsghd', p.astype(v_cmp.dtype), v_cmp)
    return o, p


def select_blocks(p_cmp, pos):
    S = pos.shape[0]
    nb = S // SEL_BLOCK
    nc = p_cmp.shape[-1]
    c_start = jnp.arange(nc) * CMP_STRIDE
    j_start = jnp.arange(nb) * SEL_BLOCK
    overlap = ((c_start[:, None] < j_start[None] + SEL_BLOCK)
               & (c_start[:, None] + CMP_BLOCK > j_start[None])).astype(F32)
    imp = jnp.einsum('bghsc,cn->bsgn', p_cmp, overlap)
    cur = pos // SEL_BLOCK
    jj = jnp.arange(nb)
    forced = (jj[None] == 0) | (jj[None] == cur[:, None]) | (jj[None] == cur[:, None] - 1)
    causal = j_start[None] <= pos[:, None]
    score = jnp.where(forced[None, :, None, :], BIG,
                      jnp.where(causal[None, :, None, :], imp, NEG))
    _, idx = lax.top_k(score, min(N_SEL, nb))
    return idx


def slc_branch(q, k_slc, v_slc, idx, pos):
    B_, S = q.shape[:2]
    nb = S // SEL_BLOCK
    kb = k_slc.reshape(B_, nb, SEL_BLOCK, N_KV, HEAD_DIM).transpose(0, 3, 1, 2, 4)
    vb = v_slc.reshape(B_, nb, SEL_BLOCK, N_KV, HEAD_DIM).transpose(0, 3, 1, 2, 4)
    nq = S // SEL_QCHUNK
    kk = idx.shape[-1]
    bi = jnp.arange(B_)[:, None, None, None]
    gi = jnp.arange(N_KV)[None, None, :, None]

    def chunk(args):
        q_c, idx_c, t_c = args
        k_g = kb[bi, gi, idx_c]
        v_g = vb[bi, gi, idx_c]
        s = jnp.einsum('bqghd,bqgksd->bqghks', q_c, k_g).astype(F32)
        kpos = idx_c[..., None] * SEL_BLOCK + jnp.arange(SEL_BLOCK)
        mask = (kpos <= t_c[None, :, None, None, None])[:, :, :, None]
        s = jnp.where(mask, s, NEG)
        p = jax.nn.softmax(s.reshape(s.shape[:4] + (kk * SEL_BLOCK,)), -1).reshape(s.shape)
        return jnp.einsum('bqghks,bqgksd->bqghd', p.astype(v_g.dtype), v_g)

    qs = q.reshape(B_, nq, SEL_QCHUNK, N_KV, HPG, HEAD_DIM).swapaxes(0, 1)
    ids = idx.reshape(B_, nq, SEL_QCHUNK, N_KV, kk).swapaxes(0, 1)
    ts = pos.reshape(nq, SEL_QCHUNK)
    o = lax.map(chunk, (qs, ids, ts))
    return o.swapaxes(0, 1).reshape(B_, S, N_KV, HPG, HEAD_DIM)


def win_branch(q, k, v):
    B_, S = q.shape[:2]
    nqb = S // WIN_QBLOCK
    nback = WINDOW // WIN_QBLOCK

    def bands(t):
        tp = jnp.pad(t, ((0, 0), (WINDOW, 0), (0, 0), (0, 0)))
        tp = tp.reshape(B_, nqb + nback, WIN_QBLOCK, N_KV, HEAD_DIM)
        return jnp.concatenate([tp[:, j:j + nqb] for j in range(nback + 1)], axis=2)

    kw, vw = bands(k), bands(v)
    qb = q.reshape(B_, nqb, WIN_QBLOCK, N_KV, HPG, HEAD_DIM)
    s = jnp.einsum('bnighd,bnjgd->bnghij', qb, kw).astype(F32)
    i = jnp.arange(WIN_QBLOCK)[:, None]
    j = jnp.arange(WINDOW + WIN_QBLOCK)[None]
    rel = i + WINDOW - j
    kpos = jnp.arange(nqb)[:, None, None] * WIN_QBLOCK - WINDOW + j
    mask = (rel >= 0) & (rel < WINDOW) & (kpos >= 0)
    p = jax.nn.softmax(jnp.where(mask[None, :, None, None], s, NEG), -1)
    o = jnp.einsum('bnghij,bnjgd->bnighd', p.astype(vw.dtype), vw)
    return o.reshape(B_, S, N_KV, HPG, HEAD_DIM)


def nsa_mixer(x, w_qg, w_o, k_cmp, v_cmp, k_slc, v_slc, k_win, v_win):
    B_, S, _ = x.shape
    qg = x @ w_qg
    q = qg[..., :N_HEADS * HEAD_DIM].reshape(B_, S, N_KV, HPG, HEAD_DIM) * (HEAD_DIM ** -0.5)
    gates = jax.nn.sigmoid(qg[..., N_HEADS * HEAD_DIM:].astype(F32)).reshape(B_, S, N_KV, HPG, 3)
    pos = jnp.arange(S)
    q_rot = partial_rope(q, pos)
    o_cmp, p_cmp = cmp_branch(q, k_cmp, v_cmp, pos)
    idx = select_blocks(p_cmp, pos)
    o_slc = slc_branch(q_rot, k_slc, v_slc, idx, pos)
    o_win = win_branch(q_rot, k_win, v_win)
    o = (gates[..., 0:1] * o_cmp + gates[..., 1:2] * o_slc + gates[..., 2:3] * o_win).astype(x.dtype)
    return o.reshape(B_, S, N_HEADS * HEAD_DIM) @ w_o


def setup_inputs(seed: int = 0) -> dict:
    key = jax.random.key(seed)
    ks = jax.random.split(key, 26)

    def nrm(k, shape, scale):
        return jax.random.normal(k, shape, F32) * scale

    nA, nB = N_A_LAYERS, N_B_LAYERS
    n_dense = (DEPTH + 1) // 2
    n_moe = DEPTH // 2
    u = jax.random.uniform(ks[9], (nA, LRU_WIDTH), F32, 0.9, 0.999)
    s = u ** (1.0 / LRU_C)
    lam = jnp.log(s) - jnp.log1p(-s)
    return {
        'x': nrm(ks[0], (BATCH, SEQ, D_MODEL), 1.0),
        'ln_g': 1.0 + nrm(ks[1], (DEPTH, 2, D_MODEL), 0.02),
        'ln_b': nrm(ks[2], (DEPTH, 2, D_MODEL), 0.02),
        'lru_w_in': nrm(ks[3], (nA, D_MODEL, 2 * LRU_WIDTH), D_MODEL ** -0.5),
        'lru_conv_w': nrm(ks[4], (nA, CONV_WIDTH, LRU_WIDTH), CONV_WIDTH ** -0.5),
        'lru_conv_b': nrm(ks[5], (nA, LRU_WIDTH), 0.01),
        'lru_w_a': nrm(ks[6], (nA, LRU_BLOCKS, LRU_BW, LRU_BW), LRU_BW ** -0.5),
        'lru_b_a': nrm(ks[7], (nA, LRU_BLOCKS, LRU_BW), 0.01),
        'lru_w_i': nrm(ks[8], (nA, LRU_BLOCKS, LRU_BW, LRU_BW), LRU_BW ** -0.5),
        'lru_b_i': nrm(ks[10], (nA, LRU_BLOCKS, LRU_BW), 0.01),
        'lru_lambda': lam,
        'lru_w_out': nrm(ks[11], (nA, LRU_WIDTH, D_MODEL), LRU_WIDTH ** -0.5 * DN_BETA),
        'nsa_w_kv': nrm(ks[12], (D_MODEL, 6 * N_KV * HEAD_DIM), D_MODEL ** -0.5),
        'nsa_cmp_pos': nrm(ks[13], (2, CMP_BLOCK, HEAD_DIM), 0.1),
        'nsa_cmp_w1': nrm(ks[14], (2, CMP_BLOCK * HEAD_DIM, CMP_HIDDEN), (CMP_BLOCK * HEAD_DIM) ** -0.5),
        'nsa_cmp_w2': nrm(ks[15], (2, CMP_HIDDEN, HEAD_DIM), CMP_HIDDEN ** -0.5),
        'nsa_w_qg': nrm(ks[16], (nB, D_MODEL, N_HEADS * HEAD_DIM + 3 * N_HEADS), D_MODEL ** -0.5),
        'nsa_w_o': nrm(ks[17], (nB, N_HEADS * HEAD_DIM, D_MODEL), (N_HEADS * HEAD_DIM) ** -0.5 * DN_BETA),
        'ffn_w_gu': nrm(ks[18], (n_dense, D_MODEL, 2 * D_FF), D_MODEL ** -0.5),
        'ffn_w_down': nrm(ks[19], (n_dense, D_FF, D_MODEL), D_FF ** -0.5 * DN_BETA),
        'moe_w_router': nrm(ks[20], (n_moe, D_MODEL, N_EXPERTS), D_MODEL ** -0.5),
        'moe_w_gu': nrm(ks[21], (n_moe, N_EXPERTS, D_MODEL, 2 * MOE_D_FF), D_MODEL ** -0.5),
        'moe_w_down': nrm(ks[22], (n_moe, N_EXPERTS, MOE_D_FF, D_MODEL), MOE_D_FF ** -0.5 * DN_BETA),
    }


def reference(x, ln_g, ln_b, lru_w_in, lru_conv_w, lru_conv_b, lru_w_a, lru_b_a, lru_w_i, lru_b_i,
              lru_lambda, lru_w_out, nsa_w_kv, nsa_cmp_pos, nsa_cmp_w1, nsa_cmp_w2, nsa_w_qg, nsa_w_o,
              ffn_w_gu, ffn_w_down, moe_w_router, moe_w_gu, moe_w_down):
    h = x
    shared_kv = None
    for l in range(DEPTH):
        if l < N_A_LAYERS:
            y = recurrent_block(h, lru_w_in[l], lru_conv_w[l], lru_conv_b[l], lru_w_a[l], lru_b_a[l],
                                lru_w_i[l], lru_b_i[l], lru_lambda[l], lru_w_out[l])
        else:
            lb = l - N_A_LAYERS
            y = nsa_mixer(h, nsa_w_qg[lb], nsa_w_o[lb], *shared_kv)
        h = post_norm(h, y, ln_g[l, 0], ln_b[l, 0])
        if l % 2 == 0:
            f = swiglu(h, ffn_w_gu[l // 2], ffn_w_down[l // 2])
        else:
            f = moe_swiglu(h, moe_w_router[l // 2], moe_w_gu[l // 2], moe_w_down[l // 2])
        h = post_norm(h, f, ln_g[l, 1], ln_b[l, 1])
        if l == N_A_LAYERS - 1:
            shared_kv = nsa_shared_kv(h, nsa_w_kv, nsa_cmp_pos, nsa_cmp_w1, nsa_cmp_w2)
    return h
```

```cpp
#include <hip/hip_runtime.h>
#include <cstdio>
#include <cstdint>

#define GAS __attribute__((address_space(1)))
#define LAS __attribute__((address_space(3)))
typedef unsigned short bf16;
typedef unsigned v4u __attribute__((ext_vector_type(4)));
typedef unsigned v2u __attribute__((ext_vector_type(2)));
typedef float f32x4 __attribute__((ext_vector_type(4)));
typedef float f32x2 __attribute__((ext_vector_type(2)));
typedef float f32x16 __attribute__((ext_vector_type(16)));
typedef short bf16x8 __attribute__((ext_vector_type(8)));
typedef short s16x4 __attribute__((ext_vector_type(4)));
typedef GAS unsigned gu32;
#define RLX_AGENT __ATOMIC_RELAXED, __HIP_MEMORY_SCOPE_AGENT
#define LDS_WAIT() asm volatile("s_waitcnt lgkmcnt(0)" ::: "memory")
#define VM_WAIT() asm volatile("s_waitcnt vmcnt(0)" ::: "memory")

constexpr int BATCH = 16, SEQ = 2048, DM = 1024, T = BATCH * SEQ;
constexpr int LRU_BLOCKS = 8, LRU_BW = 128;
constexpr int NHEAD = 16, HD = 64, NKV = 4, HPG = 4;
constexpr int DFF = 2816, NEXP = 8, MFF = 3584;
constexpr int NQG = 1072, NQG_PAD = 1280, NKVP = 1536;
constexpr int CMP_HID = 256, NCMP = 127, NCMP_PAD = 128;
constexpr float DN_ALPHA = 1.681792830507429f;
constexpr float LN_EPS = 1e-5f;
constexpr int MOE_ROWS = 2 * T + NEXP * 256;
constexpr int NWAVES = 8;

constexpr size_t MiB = 1u << 20;
constexpr size_t WS_CTL = 0, CTL_ZERO_BYTES = 1 * MiB;
constexpr size_t WS_ROPE = 1 * MiB;
constexpr size_t WS_C8SP = WS_ROPE + 256 * 1024;
constexpr size_t WS_CBIAS = WS_C8SP + 16 * 1024;
constexpr size_t WS_ROUTE = 2 * MiB;
constexpr size_t WS_ROWS = 3 * MiB;
constexpr size_t WS_SA = 4 * MiB, WS_SH = 6 * MiB, WS_CI = 8 * MiB;
constexpr size_t WS_KCMP = 10 * MiB;
constexpr size_t WS_CH = 12 * MiB;
constexpr size_t WS_GT = 20 * MiB;
constexpr size_t WS_W = 64 * MiB;
constexpr size_t W_IN = WS_W;
constexpr size_t W_GATE = W_IN + (size_t)2 * 2048 * 1024 * 2;
constexpr size_t W_OUT = W_GATE + (size_t)2 * 2048 * 128 * 2;
constexpr size_t W_KV = W_OUT + (size_t)2 * 1024 * 1024 * 2;
constexpr size_t W_C1 = W_KV + (size_t)1536 * 1024 * 2;
constexpr size_t W_QG = W_C1 + (size_t)2 * 256 * 2048 * 2;
constexpr size_t W_O = W_QG + (size_t)2 * 1280 * 1024 * 2;
constexpr size_t W_GU = W_O + (size_t)2 * 1024 * 1024 * 2;
constexpr size_t W_DN = W_GU + (size_t)2 * 5632 * 1024 * 2;
constexpr size_t MW_GU = W_DN + (size_t)2 * 1024 * 2816 * 2;
constexpr size_t MW_DN = MW_GU + (size_t)2 * 8 * 7168 * 1024 * 2;
constexpr size_t W_END = MW_DN + (size_t)2 * 8 * 1024 * 3584 * 2;
constexpr size_t WS_HF = 480 * MiB;
constexpr size_t WS_Y = 608 * MiB;
constexpr size_t WS_HB = 672 * MiB;
constexpr size_t WS_S = 736 * MiB;
constexpr size_t WS_GATE = WS_S, WS_UX = WS_S + 64 * MiB, WS_XR = WS_S + 128 * MiB, WS_AF = WS_S + 192 * MiB, WS_BF = WS_S + 320 * MiB, WS_HG = WS_UX;
constexpr size_t WS_ACT = WS_S;
constexpr size_t WS_AS = WS_S;
constexpr size_t WS_HS = WS_S + 136 * MiB;
constexpr size_t WS_YM = WS_S + 600 * MiB;
constexpr size_t WS_Q = WS_S, WS_QR = WS_S + 64 * MiB, WS_O = WS_S + 128 * MiB;
constexpr size_t WS_KVT = WS_S + 736 * MiB;
constexpr size_t WS_END = WS_KVT + 100 * MiB;
static_assert(W_END <= WS_HF, "weights overflow");
static_assert(WS_HS + (size_t)MOE_ROWS * MFF * 2 <= WS_YM, "HS overflow");
static_assert(WS_YM + (size_t)MOE_ROWS * DM * 2 <= WS_KVT, "YM overflow");
static_assert(WS_BF + (size_t)T * DM * 4 <= WS_KVT, "BF overflow");

constexpr int CW_BAR = 4096;
constexpr int CW_CNT = 16384;

constexpr int RING_BYTES = 131072;
constexpr int LDSCTL_OFF = RING_BYTES, MISC_OFF = LDSCTL_OFF + 320;
constexpr int LDS_BYTES = 147456;

__device__ __forceinline__ unsigned f2bf(float f) { unsigned u = __builtin_bit_cast(unsigned, f); return (u + 0x7fffu + ((u >> 16) & 1u)) >> 16; }
__device__ __forceinline__ unsigned pk2(float lo, float hi) { return f2bf(lo) | (f2bf(hi) << 16); }
__device__ __forceinline__ unsigned cvt_pk_bf16(float lo, float hi) { unsigned r; asm volatile("v_cvt_pk_bf16_f32 %0, %1, %2" : "=v"(r) : "v"(lo), "v"(hi)); return r; }
__device__ __forceinline__ float bf_lo(unsigned w) { return __uint_as_float(w << 16); }
__device__ __forceinline__ float bf_hi(unsigned w) { return __uint_as_float(w & 0xffff0000u); }
__device__ __forceinline__ float fast_exp(float x) { return __builtin_amdgcn_exp2f(x * 1.4426950408889634f); }
__device__ __forceinline__ float fast_rcp(float x) { return __builtin_amdgcn_rcpf(x); }
__device__ __forceinline__ float sigmoidf_(float x) { return fast_rcp(1.0f + fast_exp(-x)); }
__device__ __forceinline__ float gelu_tanh(float x) { const float u = 1.5957691216057308f * (x + 0.044715f * x * x * x); return x * fast_rcp(1.0f + fast_exp(-u)); }
__device__ __forceinline__ float silu_(float x) { return x * fast_rcp(1.0f + fast_exp(-x)); }
__device__ __forceinline__ float wave_sum(float v) {
#pragma unroll
    for (int o = 1; o < 64; o <<= 1) v += __shfl_xor(v, o);
    return v;
}
namespace pg8 {
#define PG8_LAS __attribute__((address_space(3)))
typedef unsigned short bf16_t;
typedef unsigned u32x4 __attribute__((ext_vector_type(4)));
constexpr int BM = 256, BK = 64, HALF = 128, HTB = HALF * BK * 2, STAGE_BYTES = 8 * HTB, NXCD = 8, WGM = 8;
__host__ __device__ __forceinline__ int lds_byte(int r, int c) { const int st = (r >> 4) * 2 + (c >> 5), rr = r & 15, cc = c & 31, ob = rr * 64 + cc * 2; return st * 1024 + (ob ^ (((ob >> 9) & 1) << 5)); }
__host__ __device__ __forceinline__ void stage_rc(int b, int& R, int& C) { const int st = b / 1024, sb = b % 1024, swz = sb ^ (((sb >> 9) & 1) << 5); R = (st >> 1) * 16 + swz / 64; C = (st & 1) * 32 + (swz % 64) / 2; }
__host__ __device__ __forceinline__ int perm32(int rho) { const int n = rho >> 4, i = rho & 15; return 8 * (i >> 2) + 4 * n + (i & 3); }

struct Unit { int pm, pn, aux; size_t aoff, boff; };
struct Gemm { const bf16_t* A; const bf16_t* Bt; int lda, ldb, K; };

struct DenseOrder {
    int nM, nN, nwg, G, c; size_t a_pm, a_pn, b_pn;
    __device__ __forceinline__ void init(int nM_, int nN_, int G_, int c_, size_t a_pm_, size_t a_pn_, size_t b_pn_) { nM = nM_; nN = nN_; nwg = nM * nN; G = G_; c = c_; a_pm = a_pm_; a_pn = a_pn_; b_pn = b_pn_; }
    __device__ __forceinline__ bool next(int i, Unit& u) const {
        const long L = (long)i * G + c; if (L >= nwg) return false;
        int wgid = (int)L; { const int q = nwg / NXCD, r = nwg % NXCD, xcd = wgid % NXCD, off = wgid / NXCD; wgid = (xcd < r ? xcd * (q + 1) : r * (q + 1) + (xcd - r) * q) + off; }
        const int nig = WGM * nN, gid = wgid / nig, fm = gid * WGM, gsz = (nM - fm) < WGM ? (nM - fm) : WGM;
        u.pm = fm + ((wgid % nig) % gsz); u.pn = (wgid % nig) / gsz; u.aux = 0;
        u.aoff = (size_t)u.pm * a_pm + (size_t)u.pn * a_pn; u.boff = (size_t)u.pn * b_pn; return true;
    }
};
struct GroupOrder {
    int t1, t2, t3, t4, t5, t6, t7, t8; int nNe, total, G, c; size_t a_pm, b_tile;
    __device__ __forceinline__ bool next(int i, Unit& u) const {
        const long L = (long)i * G + c; if (L >= total) return false;
        const int pm = (int)(L / nNe), pn = (int)(L % nNe);
        const int e = (pm >= t1) + (pm >= t2) + (pm >= t3) + (pm >= t4) + (pm >= t5) + (pm >= t6) + (pm >= t7);
        u.pm = pm; u.pn = pn; u.aux = e; u.aoff = (size_t)pm * a_pm; u.boff = (size_t)(e * nNe + pn) * b_tile; return true;
    }
};
template <class Epi, class Sched, bool ALIGN_EPI = false, bool SP2 = false>
__device__ __forceinline__ void gemm_phase(PG8_LAS unsigned char* lds, const Gemm g, const Sched& S, const Epi& E) {
    int tid_ = threadIdx.x; asm volatile("" : "+v"(tid_));
    const int tid = tid_, wid = __builtin_amdgcn_readfirstlane(tid >> 6), lane = tid & 63, wr = wid >> 2, wc = wid & 3, fr = lane & 15, fq = lane >> 4;
    int K_ = g.K, lda_ = g.lda, ldb_ = g.ldb; asm volatile("" : "+s"(K_), "+s"(lda_), "+s"(ldb_));
    const int K = K_, nt = K / BK; const int lda = lda_, ldb = ldb_;
    unsigned voffA[2], voffB[2];
#pragma unroll
    for (int i = 0; i < 2; ++i) { int R, C; stage_rc(tid * 16 + i * 8192, R, C); const int Rb = Epi::PERM ? ((R & ~31) + perm32(R & 31)) : R;
        voffA[i] = (unsigned)(R * lda + C) * 2u; voffB[i] = (unsigned)(Rb * ldb + C) * 2u; }
    const size_t kstep = (size_t)(BK * 2);
    const size_t hstepA = (size_t)HALF * lda * 2, hstepB = (size_t)HALF * ldb * 2;
    const unsigned ldsw = (unsigned)wid * 1024u;
    const int aoff = lds_byte(wr * 64 + fr, fq * 8), boff = lds_byte(wc * 32 + fr, fq * 8);
#define PG8_SA(b, h) (((b) * 2 + (h)) * HTB)
#define PG8_SB(b, h) ((4 + (b) * 2 + (h)) * HTB)
#define PG8_STAGE(bufoff, gbase, voff) do { _Pragma("unroll") for (int _i = 0; _i < 2; ++_i) \
        __builtin_amdgcn_global_load_lds((const unsigned*)((const char*)(gbase) + (voff)[_i]), (PG8_LAS unsigned*)(lds + (bufoff) + ldsw + _i * 8192), 16, 0, 0); } while (0)
#define PG8_LDA(dst, b, h) do { _Pragma("unroll") for (int m = 0; m < 4; ++m) _Pragma("unroll") for (int k = 0; k < 2; ++k) dst[m][k] = *(const PG8_LAS bf16x8*)(lds + PG8_SA(b, h) + aoff + m * 2048 + k * 1024); } while (0)
#define PG8_LDB(dst, b, h) do { _Pragma("unroll") for (int n = 0; n < 2; ++n) _Pragma("unroll") for (int k = 0; k < 2; ++k) dst[n][k] = *(const PG8_LAS bf16x8*)(lds + PG8_SB(b, h) + boff + n * 2048 + k * 1024); } while (0)
#define PG8_MMA(ai, bj, At, Bt) do { __builtin_amdgcn_s_setprio(1); _Pragma("unroll") for (int m = 0; m < 4; ++m) _Pragma("unroll") for (int n = 0; n < 2; ++n) _Pragma("unroll") for (int k = 0; k < 2; ++k) \
        acc[ai][bj][m][n] = __builtin_amdgcn_mfma_f32_16x16x32_bf16(Bt[n][k], At[m][k], acc[ai][bj][m][n], 0, 0, 0); __builtin_amdgcn_s_setprio(0); } while (0)
#define PG8_WAIT_V(n) asm volatile("s_waitcnt vmcnt(" #n ")" ::: "memory")
#define PG8_WAIT_L(n) asm volatile("s_waitcnt lgkmcnt(" #n ")" ::: "memory")
#define PG8_BAR __builtin_amdgcn_s_barrier()
#define PG8_SCHED __builtin_amdgcn_sched_barrier(0)
    Unit cur, nxt; int ui = 0;
    if (!S.next(0, cur)) return;
    f32x4 acc[2][2][4][2];
#pragma unroll
    for (int a = 0; a < 2; ++a)
#pragma unroll
        for (int b = 0; b < 2; ++b)
#pragma unroll
            for (int m = 0; m < 4; ++m)
#pragma unroll
                for (int n = 0; n < 2; ++n) acc[a][b][m][n] = (f32x4){0.f, 0.f, 0.f, 0.f};
    bf16x8 At[4][2], B0[2][2], B1[2][2];
    const char* cA = (const char*)g.A + cur.aoff; const char* cB = (const char*)g.Bt + cur.boff;
    if constexpr (SP2) {
        PG8_STAGE(PG8_SB(0, 0), cB, voffB); PG8_STAGE(PG8_SB(0, 1), cB + hstepB, voffB); PG8_STAGE(PG8_SA(0, 0), cA, voffA); PG8_STAGE(PG8_SA(0, 1), cA + hstepA, voffA);
        if (wr == 1) PG8_BAR;
        PG8_WAIT_V(2); PG8_BAR;
        PG8_STAGE(PG8_SB(1, 0), cB + kstep, voffB); PG8_STAGE(PG8_SA(1, 0), cA + kstep, voffA); PG8_STAGE(PG8_SB(1, 1), cB + hstepB + kstep, voffB);
        PG8_WAIT_V(6); PG8_BAR;
    } else {
        PG8_STAGE(PG8_SB(0, 0), cB, voffB); PG8_STAGE(PG8_SA(0, 0), cA, voffA); PG8_STAGE(PG8_SB(0, 1), cB + hstepB, voffB); PG8_STAGE(PG8_SA(0, 1), cA + hstepA, voffA);
        if (wr == 1) PG8_BAR;
        PG8_WAIT_V(4); PG8_BAR;
        PG8_STAGE(PG8_SB(1, 0), cB + kstep, voffB); PG8_STAGE(PG8_SA(1, 0), cA + kstep, voffA); PG8_STAGE(PG8_SB(1, 1), cB + hstepB + kstep, voffB);
        PG8_WAIT_V(6); PG8_BAR;
    }
    for (;;) {
        const bool has_next = S.next(ui + 1, nxt);
        const char* nA = has_next ? (const char*)g.A + nxt.aoff : cA; const char* nB = has_next ? (const char*)g.Bt + nxt.boff : cB;
        for (int t = 0; t < nt; t += 2) {
            const bool last = (t == nt - 2);
            const char* a1 = cA + (size_t)(t + 1) * kstep;
            const char* a2 = last ? nA : cA + (size_t)(t + 2) * kstep; const char* b2 = last ? nB : cB + (size_t)(t + 2) * kstep;
            const char* a3 = a2 + kstep; const char* b3 = b2 + kstep;
            if constexpr (SP2) {
            PG8_LDB(B0, 0, 0); PG8_LDB(B1, 0, 1); PG8_SCHED; PG8_LDA(At, 0, 0); PG8_STAGE(PG8_SA(1, 1), a1 + hstepA, voffA);
            PG8_WAIT_V(8); PG8_WAIT_L(0); PG8_BAR; PG8_MMA(0, 0, At, B0); PG8_MMA(0, 1, At, B1); PG8_BAR; PG8_SCHED;
            PG8_LDA(At, 0, 1); PG8_STAGE(PG8_SB(0, 0), b2, voffB); PG8_STAGE(PG8_SB(0, 1), b2 + hstepB, voffB); PG8_STAGE(PG8_SA(0, 0), a2, voffA);
            PG8_WAIT_V(8); PG8_WAIT_L(0); PG8_BAR; PG8_MMA(1, 0, At, B0); PG8_MMA(1, 1, At, B1); PG8_BAR; PG8_SCHED;
            PG8_LDB(B0, 1, 0); PG8_LDB(B1, 1, 1); PG8_SCHED; PG8_LDA(At, 1, 0); PG8_STAGE(PG8_SA(0, 1), a2 + hstepA, voffA);
            PG8_WAIT_V(8); PG8_WAIT_L(0); PG8_BAR; PG8_MMA(0, 0, At, B0); PG8_MMA(0, 1, At, B1); PG8_BAR; PG8_SCHED;
            PG8_LDA(At, 1, 1); PG8_STAGE(PG8_SB(1, 0), b3, voffB); PG8_STAGE(PG8_SB(1, 1), b3 + hstepB, voffB); PG8_STAGE(PG8_SA(1, 0), a3, voffA);
            PG8_WAIT_V(8); PG8_WAIT_L(0); PG8_BAR; PG8_MMA(1, 0, At, B0); PG8_MMA(1, 1, At, B1); PG8_BAR; PG8_SCHED;
            } else {
            PG8_LDB(B0, 0, 0); PG8_SCHED; PG8_LDA(At, 0, 0); PG8_STAGE(PG8_SA(1, 1), a1 + hstepA, voffA);
            PG8_WAIT_L(8); PG8_BAR; PG8_WAIT_L(0); PG8_MMA(0, 0, At, B0); PG8_BAR; PG8_SCHED;
            PG8_LDB(B1, 0, 1); PG8_STAGE(PG8_SB(0, 0), b2, voffB);
            PG8_BAR; PG8_WAIT_L(0); PG8_MMA(0, 1, At, B1); PG8_BAR;
            PG8_LDA(At, 0, 1); PG8_STAGE(PG8_SA(0, 0), a2, voffA);
            PG8_BAR; PG8_WAIT_L(0); PG8_MMA(1, 0, At, B0); PG8_BAR; PG8_SCHED;
            PG8_STAGE(PG8_SB(0, 1), b2 + hstepB, voffB);
            PG8_WAIT_V(6); PG8_BAR; PG8_MMA(1, 1, At, B1); PG8_BAR;
            PG8_LDB(B0, 1, 0); PG8_SCHED; PG8_LDA(At, 1, 0); PG8_STAGE(PG8_SA(0, 1), a2 + hstepA, voffA);
            PG8_WAIT_L(8); PG8_BAR; PG8_WAIT_L(0); PG8_MMA(0, 0, At, B0); PG8_BAR; PG8_SCHED;
            PG8_LDB(B1, 1, 1); PG8_STAGE(PG8_SB(1, 0), b3, voffB);
            PG8_BAR; PG8_WAIT_L(0); PG8_MMA(0, 1, At, B1); PG8_BAR;
            PG8_LDA(At, 1, 1); PG8_STAGE(PG8_SA(1, 0), a3, voffA);
            PG8_BAR; PG8_WAIT_L(0); PG8_MMA(1, 0, At, B0); PG8_BAR; PG8_SCHED;
            PG8_STAGE(PG8_SB(1, 1), b3 + hstepB, voffB);
            PG8_WAIT_V(6); PG8_BAR; PG8_MMA(1, 1, At, B1); PG8_BAR;
            }
        }
        if constexpr (ALIGN_EPI) { if (wr == 0) PG8_BAR; }
        { E(acc, cur, wr, wc, fr, fq); }
        if (!has_next) break;
#pragma unroll
        for (int a = 0; a < 2; ++a)
#pragma unroll
            for (int b = 0; b < 2; ++b)
#pragma unroll
                for (int m = 0; m < 4; ++m)
#pragma unroll
                    for (int n = 0; n < 2; ++n) acc[a][b][m][n] = (f32x4){0.f, 0.f, 0.f, 0.f};
        cur = nxt; cA = nA; cB = nB; ++ui;
        if constexpr (ALIGN_EPI) { if (wr == 1) PG8_BAR; }
    }
    PG8_WAIT_V(0);
    if constexpr (!ALIGN_EPI) { if (wr == 0) PG8_BAR; }
    PG8_BAR;
#undef PG8_SA
#undef PG8_SB
#undef PG8_STAGE
#undef PG8_LDA
#undef PG8_LDB
#undef PG8_MMA
#undef PG8_WAIT_V
#undef PG8_WAIT_L
#undef PG8_BAR
#undef PG8_SCHED
}

}
typedef const f32x4 (&AccT)[2][2][4][2];
using pg8::Unit;

__device__ __forceinline__ v4u pack8(const f32x4 a, const f32x4 b) {
    v4u w; w.x = cvt_pk_bf16(a[0], a[1]); w.y = cvt_pk_bf16(a[2], a[3]); w.z = cvt_pk_bf16(b[0], b[1]); w.w = cvt_pk_bf16(b[2], b[3]); return w;
}

struct EpiStore {
    static constexpr bool PERM = true;
    bf16* O; int ldc;
    __device__ __forceinline__ void operator()(AccT acc, const Unit& u, int wr, int wc, int fr, int fq) const {
        const int row0 = u.pm * 256 + wr * 64 + fr, col0 = u.pn * 256 + wc * 32 + 8 * fq;
#pragma unroll
        for (int ai = 0; ai < 2; ++ai)
#pragma unroll
            for (int m = 0; m < 4; ++m) { bf16* rowp = O + (size_t)(row0 + ai * 128 + m * 16) * ldc + col0;
#pragma unroll
                for (int bj = 0; bj < 2; ++bj) *(v4u*)(rowp + bj * 128) = pack8(acc[ai][bj][m][0], acc[ai][bj][m][1]); }
    }
};
struct EpiInProj {
    static constexpr bool PERM = true;
    bf16* GATE; bf16* UX;
    __device__ __forceinline__ void operator()(AccT acc, const Unit& u, int wr, int wc, int fr, int fq) const {
        const bool isg = u.pn < 4; bf16* O = isg ? GATE : UX;
        const int row0 = u.pm * 256 + wr * 64 + fr, col0 = (u.pn & 3) * 256 + wc * 32 + 8 * fq;
#pragma unroll
        for (int ai = 0; ai < 2; ++ai)
#pragma unroll
            for (int m = 0; m < 4; ++m) { bf16* rowp = O + (size_t)(row0 + ai * 128 + m * 16) * DM + col0;
#pragma unroll
                for (int bj = 0; bj < 2; ++bj) { f32x4 a = acc[ai][bj][m][0], b = acc[ai][bj][m][1];
                    if (isg) {
#pragma unroll
                        for (int e = 0; e < 4; ++e) { a[e] = gelu_tanh(a[e]); b[e] = gelu_tanh(b[e]); } }
                    *(v4u*)(rowp + bj * 128) = pack8(a, b); } }
    }
};
struct EpiGates {
    static constexpr bool PERM = true;
    const bf16* XR; const float* ba; const float* bi; const float* c8sp; float* AF; float* BF;
    __device__ __forceinline__ void operator()(AccT acc, const Unit& u, int wr, int wc, int fr, int fq) const {
        const int row0 = u.pm * 256 + wr * 64 + fr, ch0 = u.pn * 128 + wc * 32 + 8 * fq;
#pragma unroll
        for (int n = 0; n < 2; ++n) {
            const f32x4 vba = *(const f32x4*)(ba + ch0 + 4 * n), vbi = *(const f32x4*)(bi + ch0 + 4 * n), vsp = *(const f32x4*)(c8sp + ch0 + 4 * n);
#pragma unroll
            for (int ai = 0; ai < 2; ++ai)
#pragma unroll
                for (int m = 0; m < 4; ++m) { const unsigned off = (unsigned)(row0 + ai * 128 + m * 16) * DM + ch0 + 4 * n;
                    const v2u xw = *(const v2u*)(XR + off);
                    const float xr[4] = {bf_lo(xw.x), bf_hi(xw.x), bf_lo(xw.y), bf_hi(xw.y)};
                    f32x4 oa, ob;
#pragma unroll
                    for (int e = 0; e < 4; ++e) {
                        const float r = sigmoidf_(acc[ai][0][m][n][e] + vba[e]), ig = sigmoidf_(acc[ai][1][m][n][e] + vbi[e]);
                        const float la = -r * vsp[e], a = fast_exp(la), a2 = fast_exp(2.0f * la);
                        oa[e] = a; ob[e] = __builtin_sqrtf(fmaxf(1.0f - a2, 0.0f)) * (ig * xr[e]); }
                    *(f32x4*)(AF + off) = oa; *(f32x4*)(BF + off) = ob; }
        }
    }
};
struct EpiSwiglu {
    static constexpr bool PERM = true;
    bf16* O; int ldc;
    __device__ __forceinline__ void operator()(AccT acc, const Unit& u, int wr, int wc, int fr, int fq) const {
        const int row0 = u.pm * 256 + wr * 64 + fr, col0 = u.pn * 128 + wc * 32 + 8 * fq;
#pragma unroll
        for (int ai = 0; ai < 2; ++ai)
#pragma unroll
            for (int m = 0; m < 4; ++m) { f32x4 a, b;
#pragma unroll
                for (int e = 0; e < 4; ++e) { a[e] = silu_(acc[ai][0][m][0][e]) * acc[ai][1][m][0][e]; b[e] = silu_(acc[ai][0][m][1][e]) * acc[ai][1][m][1][e]; }
                *(v4u*)(O + (size_t)(row0 + ai * 128 + m * 16) * ldc + col0) = pack8(a, b); }
    }
};
__device__ __forceinline__ void rope8(f32x4& a, f32x4& b, bool lowhalf, bool active, const f32x2* cs  ) {
    f32x4 pa, pb;
#pragma unroll
    for (int e = 0; e < 4; ++e) { pa[e] = __shfl_xor(a[e], 16); pb[e] = __shfl_xor(b[e], 16); }
    if (active) {
        const f32x4 c01 = *(const f32x4*)(cs), c23 = *(const f32x4*)(cs + 2), c45 = *(const f32x4*)(cs + 4), c67 = *(const f32x4*)(cs + 6);
        const float co[8] = {c01[0], c01[2], c23[0], c23[2], c45[0], c45[2], c67[0], c67[2]}, si[8] = {c01[1], c01[3], c23[1], c23[3], c45[1], c45[3], c67[1], c67[3]};
#pragma unroll
        for (int e = 0; e < 4; ++e) {
            if (lowhalf) { a[e] = a[e] * co[e] - pa[e] * si[e]; b[e] = b[e] * co[4 + e] - pb[e] * si[4 + e]; }
            else { a[e] = a[e] * co[e] + pa[e] * si[e]; b[e] = b[e] * co[4 + e] + pb[e] * si[4 + e]; }
        }
    }
}
struct EpiKV {
    static constexpr bool PERM = true;
    bf16* KVT; const f32x2* rope;
    __device__ __forceinline__ void operator()(AccT acc, const Unit& u, int wr, int wc, int fr, int fq) const {
        const int j = u.pn; const bool dorope = (j == 2 || j == 4) && ((wc & 1) == 0);
        const int row0 = u.pm * 256 + wr * 64 + fr, d0 = 32 * (wc & 1) + 8 * fq;
#pragma unroll
        for (int ai = 0; ai < 2; ++ai)
#pragma unroll
            for (int m = 0; m < 4; ++m) { const int row = row0 + ai * 128 + m * 16, b = row >> 11, s = row & 2047;
#pragma unroll
                for (int bj = 0; bj < 2; ++bj) { const int g = 2 * bj + (wc >> 1);
                    f32x4 a = acc[ai][bj][m][0], bq = acc[ai][bj][m][1];
                    if (dorope) rope8(a, bq, fq == 0, fq < 2, rope + s * 8);
                    *(v4u*)(KVT + ((size_t)((j * BATCH + b) * NKV + g) * SEQ + s) * HD + d0) = pack8(a, bq); } }
    }
};
struct EpiQG {
    static constexpr bool PERM = true;
    bf16* Q; bf16* QR; float* GT; const f32x2* rope;
    __device__ __forceinline__ void operator()(AccT acc, const Unit& u, int wr, int wc, int fr, int fq) const {
        const int row0 = u.pm * 256 + wr * 64 + fr;
        if (u.pn < 4) {
            const int col0 = u.pn * 256 + wc * 32 + 8 * fq; const bool dorope = (wc & 1) == 0;
#pragma unroll
            for (int ai = 0; ai < 2; ++ai)
#pragma unroll
                for (int m = 0; m < 4; ++m) { const int row = row0 + ai * 128 + m * 16, s = row & 2047;
#pragma unroll
                    for (int bj = 0; bj < 2; ++bj) { f32x4 a = acc[ai][bj][m][0] * 0.125f, bq = acc[ai][bj][m][1] * 0.125f;
                        const size_t off = (size_t)row * DM + col0 + bj * 128;
                        *(v4u*)(Q + off) = pack8(a, bq);
                        if (dorope) rope8(a, bq, fq == 0, fq < 2, rope + s * 8);
                        *(v4u*)(QR + off) = pack8(a, bq); } }
        } else {
            const int col0 = wc * 32 + 8 * fq;
            if (col0 < 48) {
#pragma unroll
                for (int ai = 0; ai < 2; ++ai)
#pragma unroll
                    for (int m = 0; m < 4; ++m) { const int row = row0 + ai * 128 + m * 16; f32x4 a = acc[ai][0][m][0], bq = acc[ai][0][m][1];
#pragma unroll
                        for (int e = 0; e < 4; ++e) { a[e] = sigmoidf_(a[e]); bq[e] = sigmoidf_(bq[e]); }
                        *(f32x4*)(GT + (size_t)row * 64 + col0) = a; *(f32x4*)(GT + (size_t)row * 64 + col0 + 4) = bq; }
            }
        }
    }
};
struct EpiCmp {
    static constexpr bool PERM = true;
    bf16* CH; const float* bias;
    __device__ __forceinline__ void operator()(AccT acc, const Unit& u, int wr, int wc, int fr, int fq) const {
        const int j = u.pn, row0 = u.pm * 256 + wr * 64 + fr, col0 = wc * 32 + 8 * fq;
        bf16* O = CH + (size_t)j * 8192 * 256;
        float bv[2][8];
#pragma unroll
        for (int bj = 0; bj < 2; ++bj)
#pragma unroll
            for (int e = 0; e < 8; ++e) bv[bj][e] = bias[j * 256 + bj * 128 + col0 + e];
#pragma unroll
        for (int ai = 0; ai < 2; ++ai)
#pragma unroll
            for (int m = 0; m < 4; ++m) { bf16* rowp = O + (size_t)(row0 + ai * 128 + m * 16) * 256 + col0;
#pragma unroll
                for (int bj = 0; bj < 2; ++bj) { f32x4 a = acc[ai][bj][m][0], b = acc[ai][bj][m][1];
#pragma unroll
                    for (int e = 0; e < 4; ++e) { a[e] = gelu_tanh(a[e] + bv[bj][e]); b[e] = gelu_tanh(b[e] + bv[bj][4 + e]); }
                    *(v4u*)(rowp + bj * 128) = pack8(a, b); } }
    }
};
#define XB_TMO      128
#define XB_XCNT(j)  (256  + 64 * (j))
#define XB_XSUB(j)  (1280 + 64 * (j))
#define XB_XGEN(j)  (2304 + 64 * (j))
#define XB_TOP      3328
#define XB_TOPGEN   3392
#define XCD_BAR_WORDS 3456
#define XB_SPIN_CAP (1u << 18)
__device__ __forceinline__ unsigned xb_ld(unsigned* p)              { return __hip_atomic_load(p, __ATOMIC_RELAXED, __HIP_MEMORY_SCOPE_AGENT); }
__device__ __forceinline__ unsigned xb_add(unsigned* p, unsigned v) { return __hip_atomic_fetch_add(p, v, __ATOMIC_RELAXED, __HIP_MEMORY_SCOPE_AGENT); }
__device__ __forceinline__ unsigned xb_xcc_id() { return (unsigned)__builtin_amdgcn_s_getreg((3 << 11) | 20) & 0xFu; }
#define XB_SPIN(cond, bar) do { unsigned _sp = 0; while (cond) { __builtin_amdgcn_s_sleep(1); \
    if ((++_sp & 255u) == 0u) { if (xb_ld(&(bar)[XB_TMO])) break; if (_sp > XB_SPIN_CAP) { atomicAdd(&(bar)[XB_TMO], 1u); break; } } } } while (0)
struct XcdBarrier { unsigned* bar; unsigned x; volatile LAS unsigned* st; };
__device__ __forceinline__ XcdBarrier xcd_barrier_post(unsigned* bar, volatile LAS unsigned* st) {
    XcdBarrier b; b.bar = bar; b.x = (unsigned)__builtin_amdgcn_readfirstlane((int)xb_xcc_id()); b.st = st;
    if (threadIdx.x == 0) (void)xb_add(&bar[XB_XCNT(b.x)], 1u);
    return b;
}
__device__ __forceinline__ void xcd_barrier_complete(unsigned* bar, unsigned x, unsigned& nloc, unsigned& nx) {
    const unsigned G = gridDim.x * gridDim.y * gridDim.z;
    unsigned sum, cnt, mine, sp = 0u;
    for (;;) {
        sum = 0u; cnt = 0u; mine = 0u;
#pragma unroll
        for (unsigned j = 0; j < 16; ++j) { const unsigned c = xb_ld(&bar[XB_XCNT(j)]); sum += c; cnt += (c > 0u) ? 1u : 0u; mine = (j == x) ? c : mine; }
        if (sum == G) break;
        __builtin_amdgcn_s_sleep(1);
        if ((++sp & 255u) == 0u) { if (xb_ld(&bar[XB_TMO])) break; if (sp > XB_SPIN_CAP) { atomicAdd(&bar[XB_TMO], 1u); break; } }
    }
    nloc = mine > 0u ? mine : 1u; nx = cnt > 0u ? cnt : 1u;
}
__device__ __forceinline__ void xcd_barrier(const XcdBarrier& b) {
    asm volatile("s_waitcnt vmcnt(0)" ::: "memory");
    __syncthreads();
    if (threadIdx.x == 0) {
        unsigned long zb_ = 0; unsigned bx_ = b.x; asm volatile("" : "+s"(zb_), "+s"(bx_)); unsigned* bar = b.bar + zb_;
        __builtin_amdgcn_s_waitcnt(0);
        unsigned nloc = b.st[0], nx = b.st[1];
        if (nloc == 0u) { xcd_barrier_complete(bar, bx_, nloc, nx); b.st[0] = nloc; b.st[1] = nx; }
        const unsigned old = xb_add(&bar[XB_XSUB(bx_)], 1u);
        const unsigned gen = old / nloc;
        if (old + 1u == (gen + 1u) * nloc) {
            __builtin_amdgcn_fence(__ATOMIC_RELEASE, "agent");
            asm volatile("s_waitcnt vmcnt(0)" ::: "memory");
            const unsigned og = xb_add(&bar[XB_TOP], 1u);
            const unsigned tg = og / nx;
            if (og + 1u == (tg + 1u) * nx) xb_add(&bar[XB_TOPGEN], 1u);
            else XB_SPIN(xb_ld(&bar[XB_TOPGEN]) == tg, bar);
            __builtin_amdgcn_fence(__ATOMIC_ACQUIRE, "agent");
            xb_add(&bar[XB_XGEN(bx_)], 1u);
            asm volatile("s_waitcnt vmcnt(0)" ::: "memory");
        } else {
            XB_SPIN(xb_ld(&bar[XB_XGEN(bx_)]) == gen, bar);
            __builtin_amdgcn_fence(__ATOMIC_ACQUIRE, "agent");
            asm volatile("s_waitcnt vmcnt(0)" ::: "memory");
        }
    }
    __syncthreads();
}

__device__ __forceinline__ void transpose_item(const float* W, int Nsrc, int k0, int n0, bf16* WT, size_t drow0, int ldd, LAS float* scr, int lane) {
    const int nn = n0 + (lane & 31); const bool ok = nn < Nsrc;
#pragma unroll 8
    for (int i = 0; i < 32; ++i) { const int kk = 2 * i + (lane >> 5); scr[kk * 33 + (lane & 31)] = ok ? W[(size_t)(k0 + kk) * Nsrc + nn] : 0.f; }
    LDS_WAIT(); asm volatile("" ::: "memory");
    const int c = lane & 7;
#pragma unroll
    for (int j = 0; j < 4; ++j) { const int n = (lane >> 3) + 8 * j; const LAS float* s = scr + (8 * c) * 33 + n;
        v4u o; o.x = pk2(s[0 * 33], s[1 * 33]); o.y = pk2(s[2 * 33], s[3 * 33]); o.z = pk2(s[4 * 33], s[5 * 33]); o.w = pk2(s[6 * 33], s[7 * 33]);
        *(v4u*)(WT + (drow0 + n) * ldd + k0 + 8 * c) = o; }
    LDS_WAIT(); asm volatile("" ::: "memory");
}
__device__ __forceinline__ void transpose_family(const float* src, size_t sstride, int nmat, int K, int Nsrc, int Ndst, bf16* dst, size_t dstride, int FSW, LAS float* scr, int gw, int NGW, int lane) {
    const int nkb = K / 64, nnb = Ndst / 32, per = nkb * nnb, total = per * nmat;
    for (int it = gw; it < total; it += NGW) {
        const int mat = it / per, r = it % per, kb = r / nnb, nb = r % nnb, n0 = nb * 32;
        size_t drow0 = n0;
        if (FSW > 0) { const int isu = n0 >= FSW, j = n0 - (isu ? FSW : 0); drow0 = (size_t)(j / 128) * 256 + (isu ? 128 : 0) + (j % 128); }
        transpose_item(src + (size_t)mat * sstride, Nsrc, kb * 64, n0, dst + (size_t)mat * dstride, drow0, K, scr, lane);
    }
}
__device__ __forceinline__ void sincos_d(double x, double& s, double& c) {
    const double TWO_PI = 6.283185307179586476925286766559, PI_2 = 1.5707963267948966192313216916398;
    double n = __builtin_rint(x / PI_2); double r = x - n * PI_2;
    const long q = (long)n & 3;
    const double r2 = r * r;
    double sp = r * (1.0 + r2 * (-1.0 / 6 + r2 * (1.0 / 120 + r2 * (-1.0 / 5040 + r2 * (1.0 / 362880 + r2 * (-1.0 / 39916800 + r2 * (1.0 / 6227020800.0)))))));
    double cp = 1.0 + r2 * (-0.5 + r2 * (1.0 / 24 + r2 * (-1.0 / 720 + r2 * (1.0 / 40320 + r2 * (-1.0 / 3628800 + r2 * (1.0 / 479001600.0 + r2 * (-1.0 / 87178291200.0)))))));
    (void)TWO_PI;
    if (q == 0) { s = sp; c = cp; } else if (q == 1) { s = cp; c = -sp; } else if (q == 2) { s = -sp; c = -cp; } else { s = -cp; c = sp; }
}
#define FRESH_TID() int tid_f = threadIdx.x; asm volatile("" : "+v"(tid_f)); const int tid = tid_f, lane = tid & 63; (void)lane
namespace nsa {
constexpr int KROW = 144;
constexpr int KT_BYTES = 64 * KROW, VT_BYTES = 8192;
constexpr int L_KC = 0, L_VC = L_KC + 2 * KT_BYTES, L_KB = L_VC + 2 * VT_BYTES, L_VB = L_KB + 2 * KT_BYTES, L_PS = L_VB + 2 * VT_BYTES;
constexpr int L_IMP = L_PS + 8 * 8 * 128 * 4, L_UNI = L_IMP + 8 * 8 * 32 * 4, L_END = L_UNI + 64;
static_assert(L_END <= RING_BYTES, "attention LDS");
constexpr float NEGB = -1e30f, LOG2E = 1.4426950408889634f;

__device__ __forceinline__ int crow(int r, int hi) { return (r & 3) + 8 * (r >> 2) + 4 * hi; }
__device__ __forceinline__ s16x4 vtr(const LAS unsigned char* p) { return __builtin_bit_cast(s16x4, __builtin_amdgcn_ds_read_tr16_b64_v4i16((LAS s16x4*)p)); }
__device__ __forceinline__ float pmax32(float v) { return fmaxf(v, __shfl_xor(v, 32)); }

__device__ __forceinline__ void qk_tile(f32x16& p0, f32x16& p1, const LAS unsigned char* kt, const bf16x8 (&qf)[4], int r32, int hi) {
    p0 = (f32x16){0.f, 0.f, 0.f, 0.f, 0.f, 0.f, 0.f, 0.f, 0.f, 0.f, 0.f, 0.f, 0.f, 0.f, 0.f, 0.f}; p1 = p0;
#pragma unroll
    for (int d0 = 0; d0 < 4; ++d0) {
        const bf16x8 k0 = *(const LAS bf16x8*)(kt + r32 * KROW + d0 * 32 + hi * 16);
        const bf16x8 k1 = *(const LAS bf16x8*)(kt + (32 + r32) * KROW + d0 * 32 + hi * 16);
        p0 = __builtin_amdgcn_mfma_f32_32x32x16_bf16(k0, qf[d0], p0, 0, 0, 0);
        p1 = __builtin_amdgcn_mfma_f32_32x32x16_bf16(k1, qf[d0], p1, 0, 0, 0);
    }
}
__device__ __forceinline__ void pv_tile(f32x16 (&o)[2], const LAS unsigned char* vt, const bf16x8 (&pb)[4], int lane) {
    const int hi = lane >> 5;
    const LAS unsigned char* vp = vt + ((lane >> 4) & 1) * 32 + (lane & 3) * 8 + (4 * hi + ((lane & 15) >> 2)) * 64;
#pragma unroll
    for (int dh = 0; dh < 2; ++dh)
#pragma unroll
        for (int ks = 0; ks < 4; ++ks) {
            const s16x4 lo = vtr(vp + dh * 4096 + ks * 1024), hh = vtr(vp + dh * 4096 + ks * 1024 + 512);
            const bf16x8 vf = (bf16x8){lo[0], lo[1], lo[2], lo[3], hh[0], hh[1], hh[2], hh[3]};
            o[dh] = __builtin_amdgcn_mfma_f32_32x32x16_bf16(vf, pb[ks], o[dh], 0, 0, 0);
        }
}
__device__ __forceinline__ void pack_p(bf16x8 (&pb)[4], const f32x16& p0, const f32x16& p1) {
    v4u w;
    w.x = cvt_pk_bf16(p0[0], p0[1]); w.y = cvt_pk_bf16(p0[2], p0[3]); w.z = cvt_pk_bf16(p0[4], p0[5]); w.w = cvt_pk_bf16(p0[6], p0[7]); pb[0] = __builtin_bit_cast(bf16x8, w);
    w.x = cvt_pk_bf16(p0[8], p0[9]); w.y = cvt_pk_bf16(p0[10], p0[11]); w.z = cvt_pk_bf16(p0[12], p0[13]); w.w = cvt_pk_bf16(p0[14], p0[15]); pb[1] = __builtin_bit_cast(bf16x8, w);
    w.x = cvt_pk_bf16(p1[0], p1[1]); w.y = cvt_pk_bf16(p1[2], p1[3]); w.z = cvt_pk_bf16(p1[4], p1[5]); w.w = cvt_pk_bf16(p1[6], p1[7]); pb[2] = __builtin_bit_cast(bf16x8, w);
    w.x = cvt_pk_bf16(p1[8], p1[9]); w.y = cvt_pk_bf16(p1[10], p1[11]); w.z = cvt_pk_bf16(p1[12], p1[13]); w.w = cvt_pk_bf16(p1[14], p1[15]); pb[3] = __builtin_bit_cast(bf16x8, w);
}
__device__ __forceinline__ void put_k(LAS unsigned char* kt, v4u v, int tid) { *(LAS v4u*)(kt + (tid >> 3) * KROW + (tid & 7) * 16) = v; }
__device__ __forceinline__ void put_v(LAS unsigned char* vt, v4u v, int tid) { const int kv = tid >> 3, ch = tid & 7; *(LAS v4u*)(vt + (ch >> 2) * 4096 + (kv >> 4) * 1024 + (kv & 15) * 64 + (ch & 3) * 16) = v; }

template <int BR> __device__ __forceinline__ void tile_step(const LAS unsigned char* kt, const LAS unsigned char* vt, const bf16x8 (&qf)[4], int kv0, int tpos, bool blk_ok,
                                                            float& m, float& l, f32x16 (&o)[2], int lane) {
    const int r32 = lane & 31, hi = lane >> 5;
    f32x16 p0, p1; qk_tile(p0, p1, kt, qf, r32, hi);
    float mx = NEGB;
#pragma unroll
    for (int r = 0; r < 16; ++r) {
        const int ka = kv0 + crow(r, hi), kb = ka + 32;
        bool oka = ka <= tpos, okb = kb <= tpos;
        if (BR == 1) { oka = oka && (ka > tpos - 256); okb = okb && (kb > tpos - 256); } else { oka = oka && blk_ok; okb = okb && blk_ok; }
        p0[r] = oka ? p0[r] * LOG2E : NEGB; p1[r] = okb ? p1[r] * LOG2E : NEGB;
        mx = fmaxf(mx, fmaxf(p0[r], p1[r]));
    }
    mx = pmax32(mx);
    const float mn = fmaxf(m, mx), sc = __builtin_amdgcn_exp2f(m - mn); m = mn;
    float ls = 0.f;
#pragma unroll
    for (int r = 0; r < 16; ++r) { p0[r] = __builtin_amdgcn_exp2f(p0[r] - mn); p1[r] = __builtin_amdgcn_exp2f(p1[r] - mn); ls += p0[r] + p1[r]; }
    l = l * sc + ls;
#pragma unroll
    for (int r = 0; r < 16; ++r) { o[0][r] *= sc; o[1][r] *= sc; }
    bf16x8 pb[4]; pack_p(pb, p0, p1);
    pv_tile(o, vt, pb, lane);
}

__device__ __forceinline__ void attn_unit(LAS unsigned char* lds, int b, int g, int qt, const bf16* Q, const bf16* QR, const float* GT, const bf16* KVT, const bf16* KCMP, bf16* O, float* DBGP) {
    FRESH_TID(); const int r32 = lane & 31, hi = lane >> 5; const int wid = __builtin_amdgcn_readfirstlane(tid >> 6);
    const int bg = b * NKV + g;
    const int tl = r32 & 7, hh = r32 >> 3;
    const int tpos = qt * 64 + wid * 8 + tl;
    const size_t trow = (size_t)b * SEQ + tpos;
    const int head = g * HPG + hh;
    const bf16* kc = KCMP + (size_t)bg * 128 * 64; const bf16* vc = KCMP + (size_t)(64 + bg) * 128 * 64;
    const bf16* kslc = KVT + (size_t)((2 * BATCH + b) * NKV + g) * SEQ * HD; const bf16* vslc = KVT + (size_t)((3 * BATCH + b) * NKV + g) * SEQ * HD;
    const bf16* kwin = KVT + (size_t)((4 * BATCH + b) * NKV + g) * SEQ * HD; const bf16* vwin = KVT + (size_t)((5 * BATCH + b) * NKV + g) * SEQ * HD;
    LAS unsigned char* const KC = lds + L_KC; LAS unsigned char* const VC = lds + L_VC; LAS unsigned char* const KB = lds + L_KB; LAS unsigned char* const VB = lds + L_VB;
    LAS float* const PS = (LAS float*)(lds + L_PS) + wid * 8 * 128; LAS float* const IMP = (LAS float*)(lds + L_IMP) + wid * 8 * 32; LAS unsigned* const UNI = (LAS unsigned*)(lds + L_UNI);

    const int jw0 = qt >= 4 ? qt - 4 : 0, nwin = qt - jw0 + 1;
    {
        const v4u a0 = *(const v4u*)(kc + tid * 8), a1 = *(const v4u*)(kc + 4096 + tid * 8), c0 = *(const v4u*)(vc + tid * 8), c1 = *(const v4u*)(vc + 4096 + tid * 8);
        put_k(KC, a0, tid); put_k(KC + KT_BYTES, a1, tid); put_v(VC, c0, tid); put_v(VC + VT_BYTES, c1, tid);
    }
    v4u nk = *(const v4u*)(kwin + (size_t)jw0 * 4096 + tid * 8), nv = *(const v4u*)(vwin + (size_t)jw0 * 4096 + tid * 8);
    const float g_cmp = GT[trow * 64 + head * 3 + 0], g_slc = GT[trow * 64 + head * 3 + 1], g_win = GT[trow * 64 + head * 3 + 2];
    bf16x8 qf[4];
#pragma unroll
    for (int d0 = 0; d0 < 4; ++d0) qf[d0] = *(const bf16x8*)(Q + trow * DM + head * HD + d0 * 16 + hi * 8);
    LDS_WAIT(); __syncthreads();

    f32x16 of[2];
    unsigned selmask;
    unsigned uni_w;
    {
        f32x16 s0, s1, s2, s3; qk_tile(s0, s1, KC, qf, r32, hi); qk_tile(s2, s3, KC + KT_BYTES, qf, r32, hi);
        const int cmax = tpos >= 31 ? ((tpos - 31) >> 4) : -1;
        float mx = NEGB;
#pragma unroll
        for (int r = 0; r < 16; ++r) { const int c = crow(r, hi);
            s0[r] = (c <= cmax) ? s0[r] * LOG2E : NEGB; s1[r] = (c + 32 <= cmax) ? s1[r] * LOG2E : NEGB; s2[r] = (c + 64 <= cmax) ? s2[r] * LOG2E : NEGB; s3[r] = (c + 96 <= cmax) ? s3[r] * LOG2E : NEGB;
            mx = fmaxf(fmaxf(mx, fmaxf(s0[r], s1[r])), fmaxf(s2[r], s3[r])); }
        mx = pmax32(mx);
        float ls = 0.f;
#pragma unroll
        for (int r = 0; r < 16; ++r) { const int c = crow(r, hi);
            s0[r] = (c <= cmax) ? __builtin_amdgcn_exp2f(s0[r] - mx) : 0.f; s1[r] = (c + 32 <= cmax) ? __builtin_amdgcn_exp2f(s1[r] - mx) : 0.f;
            s2[r] = (c + 64 <= cmax) ? __builtin_amdgcn_exp2f(s2[r] - mx) : 0.f; s3[r] = (c + 96 <= cmax) ? __builtin_amdgcn_exp2f(s3[r] - mx) : 0.f;
            ls += (s0[r] + s1[r]) + (s2[r] + s3[r]); }
        ls += __shfl_xor(ls, 32);
        const float inv = cmax >= 0 ? 1.0f / ls : 0.f;
#pragma unroll
        for (int r = 0; r < 16; ++r) { s0[r] *= inv; s1[r] *= inv; s2[r] *= inv; s3[r] *= inv; }
#pragma unroll
        for (int r = 0; r < 16; ++r) { const int c = crow(r, hi);
            float a0 = s0[r], a1 = s1[r], a2 = s2[r], a3 = s3[r];
            a0 += __shfl_xor(a0, 8); a1 += __shfl_xor(a1, 8); a2 += __shfl_xor(a2, 8); a3 += __shfl_xor(a3, 8);
            a0 += __shfl_xor(a0, 16); a1 += __shfl_xor(a1, 16); a2 += __shfl_xor(a2, 16); a3 += __shfl_xor(a3, 16);
            if (hh == 0) { PS[tl * 128 + c] = a0; PS[tl * 128 + c + 32] = a1; PS[tl * 128 + c + 64] = a2; PS[tl * 128 + c + 96] = a3; } }
        f32x16 oc[2]; oc[0] = (f32x16){0.f, 0.f, 0.f, 0.f, 0.f, 0.f, 0.f, 0.f, 0.f, 0.f, 0.f, 0.f, 0.f, 0.f, 0.f, 0.f}; oc[1] = oc[0];
        { bf16x8 pb[4]; pack_p(pb, s0, s1); pv_tile(oc, VC, pb, lane); pack_p(pb, s2, s3); pv_tile(oc, VC + VT_BYTES, pb, lane); }
#pragma unroll
        for (int r = 0; r < 16; ++r) { of[0][r] = g_cmp * oc[0][r]; of[1][r] = g_cmp * oc[1][r]; }
        LDS_WAIT(); asm volatile("" ::: "memory");
        const int st = lane >> 3, jq = lane & 7, spos = qt * 64 + wid * 8 + st, cur = spos >> 6;
        float imp[4];
#pragma unroll
        for (int i = 0; i < 4; ++i) { const int j = jq + 8 * i; float a = 0.f;
#pragma unroll
            for (int k = -1; k < 4; ++k) { const int c = 4 * j + k; if (c >= 0) a += PS[st * 128 + c]; }
            imp[i] = a; IMP[st * 32 + j] = a; }
        LDS_WAIT(); asm volatile("" ::: "memory");
        int rank[4] = {0, 0, 0, 0};
        for (int j2 = 1; j2 < 32; ++j2) { const float v2 = IMP[st * 32 + j2]; const bool c2 = j2 <= cur - 2;
#pragma unroll
            for (int i = 0; i < 4; ++i) { const int j = jq + 8 * i; rank[i] += (c2 && (v2 > imp[i] || (v2 == imp[i] && j2 < j))) ? 1 : 0; } }
        unsigned long long bal[4];
#pragma unroll
        for (int i = 0; i < 4; ++i) { const int j = jq + 8 * i; const bool sel = (j == 0) || (j == cur) || (j == cur - 1) || (j >= 1 && j <= cur - 2 && rank[i] < 5); bal[i] = __ballot(sel); }
        selmask = 0u; uni_w = 0u;
#pragma unroll
        for (int i = 0; i < 4; ++i) { selmask |= ((unsigned)(bal[i] >> (8 * tl)) & 0xffu) << (8 * i);
#pragma unroll
            for (int t8 = 0; t8 < 8; ++t8) uni_w |= ((unsigned)(bal[i] >> (8 * t8)) & 0xffu) << (8 * i); }
        if (lane == 0) UNI[wid] = uni_w;
    }
#pragma unroll
    for (int d0 = 0; d0 < 4; ++d0) qf[d0] = *(const bf16x8*)(QR + trow * DM + head * HD + d0 * 16 + hi * 8);
    put_k(KB, nk, tid); put_v(VB, nv, tid);
    LDS_WAIT(); __syncthreads();
    unsigned uni = 0u;
#pragma unroll
    for (int w = 0; w < 8; ++w) uni |= UNI[w];
    uni = __builtin_amdgcn_readfirstlane(uni);
    const int nslc = __builtin_popcount(uni), ntile = nwin + nslc;
    float m = NEGB, l = 0.f; f32x16 o[2]; o[0] = (f32x16){0.f, 0.f, 0.f, 0.f, 0.f, 0.f, 0.f, 0.f, 0.f, 0.f, 0.f, 0.f, 0.f, 0.f, 0.f, 0.f}; o[1] = o[0];
    unsigned rem = uni; int curblk = jw0;
    for (int i = 0; i < ntile; ++i) {
        const int buf = i & 1;
        int nxtblk = 0; bool has_next = (i + 1 < ntile); bool nxt_win = (i + 1 < nwin);
        if (has_next) { if (nxt_win) nxtblk = jw0 + i + 1; else { nxtblk = __builtin_ctz(rem); rem &= rem - 1u; }
            const bf16* kp = nxt_win ? kwin : kslc; const bf16* vp = nxt_win ? vwin : vslc;
            nk = *(const v4u*)(kp + (size_t)nxtblk * 4096 + tid * 8); nv = *(const v4u*)(vp + (size_t)nxtblk * 4096 + tid * 8); }
        if (i < nwin) tile_step<1>(KB + buf * KT_BYTES, VB + buf * VT_BYTES, qf, curblk * 64, tpos, true, m, l, o, lane);
        else { if ((uni_w >> curblk) & 1u) tile_step<2>(KB + buf * KT_BYTES, VB + buf * VT_BYTES, qf, curblk * 64, tpos, ((selmask >> curblk) & 1u) != 0u, m, l, o, lane); }
        if (i == nwin - 1 || i == ntile - 1) {
            float lt = l + __shfl_xor(l, 32); const float gsc = ((i == nwin - 1) ? g_win : g_slc) / lt;
#pragma unroll
            for (int r = 0; r < 16; ++r) { of[0][r] += gsc * o[0][r]; of[1][r] += gsc * o[1][r]; o[0][r] = 0.f; o[1][r] = 0.f; }
            m = NEGB; l = 0.f;
        }
        if (has_next) { put_k(KB + (buf ^ 1) * KT_BYTES, nk, tid); put_v(VB + (buf ^ 1) * VT_BYTES, nv, tid); }
        curblk = nxtblk;
        LDS_WAIT(); __syncthreads();
    }
#ifdef DBG_ATTN_STAT
    { float st_ = 0.f; DBG_ATTN_STAT; st_ = wave_sum(st_); if (lane == 0) atomicAdd(DBGP, st_); }
#endif
    bf16* orow = O + trow * DM + head * HD;
#pragma unroll
    for (int dh = 0; dh < 2; ++dh)
#pragma unroll
        for (int k = 0; k < 4; ++k) { v2u w;
#ifdef ATTN_SCALE
            of[dh][4 * k] *= (ATTN_SCALE); of[dh][4 * k + 1] *= (ATTN_SCALE); of[dh][4 * k + 2] *= (ATTN_SCALE); of[dh][4 * k + 3] *= (ATTN_SCALE);
#endif
            w.x = cvt_pk_bf16(of[dh][4 * k], of[dh][4 * k + 1]); w.y = cvt_pk_bf16(of[dh][4 * k + 2], of[dh][4 * k + 3]);
            *(v2u*)(orow + 32 * dh + 8 * k + 4 * hi) = w; }
}
}
struct KArgs {
    const float* x; const float* ln_g; const float* ln_b; const float* lru_w_in; const float* lru_conv_w; const float* lru_conv_b; const float* lru_w_a; const float* lru_b_a;
    const float* lru_w_i; const float* lru_b_i; const float* lru_lambda; const float* lru_w_out; const float* nsa_w_kv; const float* nsa_cmp_pos; const float* nsa_cmp_w1;
    const float* nsa_cmp_w2; const float* nsa_w_qg; const float* nsa_w_o; const float* ffn_w_gu; const float* ffn_w_down; const float* moe_w_router; const float* moe_w_gu;
    const float* moe_w_down; float* out; unsigned char* ws;
};

typedef KArgs Args;
__device__ __forceinline__ unsigned char* launder_p(unsigned char* p) { asm volatile("" : "+s"(p)); return p; }
__device__ __forceinline__ const KArgs* launder_k(const KArgs* p) { asm volatile("" : "+s"(p)); return p; }

template <int MODE, bool ROUTER>
__device__ __forceinline__ void ln_phase(LAS unsigned char* lds, const float* hres, const bf16* Y, const float* ROUTE_in, const int* ROWS_in, const float* gam, const float* bet,
                                         float* outf, bf16* HB, const float* wr, float* ROUTE_out, unsigned* cnt, int gw, int NGW) {
    FRESH_TID();
    LAS float* WR = (LAS float*)lds;
    if (ROUTER) {
        for (int k = tid; k < DM; k += NWAVES * 64) { const f32x4 a = *(const f32x4*)(wr + k * 8), b = *(const f32x4*)(wr + k * 8 + 4);
            WR[0 * DM + k] = a[0]; WR[1 * DM + k] = a[1]; WR[2 * DM + k] = a[2]; WR[3 * DM + k] = a[3]; WR[4 * DM + k] = b[0]; WR[5 * DM + k] = b[1]; WR[6 * DM + k] = b[2]; WR[7 * DM + k] = b[3]; }
        LDS_WAIT(); __syncthreads();
    }
    f32x4 gv[4], bv[4];
#pragma unroll
    for (int j = 0; j < 4; ++j) { gv[j] = *(const f32x4*)(gam + 4 * lane + 256 * j); bv[j] = *(const f32x4*)(bet + 4 * lane + 256 * j); }
    for (int m = gw; m < T; m += NGW) {
        f32x4 v[4]; float s = 0.f;
        const float* hr = hres + (size_t)m * DM + 4 * lane;
        if (MODE == 0) {
            const bf16* yr = Y + (size_t)m * DM + 4 * lane;
#pragma unroll
            for (int j = 0; j < 4; ++j) { const f32x4 h = *(const f32x4*)(hr + 256 * j); const v2u y = *(const v2u*)(yr + 256 * j);
                v[j][0] = DN_ALPHA * h[0] + bf_lo(y.x); v[j][1] = DN_ALPHA * h[1] + bf_hi(y.x); v[j][2] = DN_ALPHA * h[2] + bf_lo(y.y); v[j][3] = DN_ALPHA * h[3] + bf_hi(y.y); }
        } else {
            const int r1 = ROWS_in[2 * m], r2 = ROWS_in[2 * m + 1];
#ifdef DROP_MOE
            const float w1 = 0.f, w2 = 0.f;
#else
            const float w1 = ROUTE_in[(size_t)m * 8 + 4], w2 = ROUTE_in[(size_t)m * 8 + 5];
#endif
            const bf16* y1 = Y + (size_t)r1 * DM + 4 * lane; const bf16* y2 = Y + (size_t)r2 * DM + 4 * lane;
#pragma unroll
            for (int j = 0; j < 4; ++j) { const f32x4 h = *(const f32x4*)(hr + 256 * j); const v2u a = *(const v2u*)(y1 + 256 * j), b = *(const v2u*)(y2 + 256 * j);
                v[j][0] = DN_ALPHA * h[0] + (w1 * bf_lo(a.x) + w2 * bf_lo(b.x)); v[j][1] = DN_ALPHA * h[1] + (w1 * bf_hi(a.x) + w2 * bf_hi(b.x));
                v[j][2] = DN_ALPHA * h[2] + (w1 * bf_lo(a.y) + w2 * bf_lo(b.y)); v[j][3] = DN_ALPHA * h[3] + (w1 * bf_hi(a.y) + w2 * bf_hi(b.y)); }
        }
#pragma unroll
        for (int j = 0; j < 4; ++j) s += (v[j][0] + v[j][1]) + (v[j][2] + v[j][3]);
        const float mean = wave_sum(s) * (1.f / DM); float s2 = 0.f;
#pragma unroll
        for (int j = 0; j < 4; ++j) { v[j] = v[j] - mean; s2 += (v[j][0] * v[j][0] + v[j][1] * v[j][1]) + (v[j][2] * v[j][2] + v[j][3] * v[j][3]); }
        const float rstd = 1.f / __builtin_sqrtf(wave_sum(s2) * (1.f / DM) + LN_EPS);
#pragma unroll
        for (int j = 0; j < 4; ++j) { v[j] = v[j] * rstd * gv[j] + bv[j];
            *(f32x4*)(outf + (size_t)m * DM + 4 * lane + 256 * j) = v[j];
            v2u w; w.x = cvt_pk_bf16(v[j][0], v[j][1]); w.y = cvt_pk_bf16(v[j][2], v[j][3]); *(v2u*)(HB + (size_t)m * DM + 4 * lane + 256 * j) = w; }
        if (ROUTER) {
            float lg[8];
#pragma unroll
            for (int e = 0; e < 8; ++e) { float a = 0.f;
#pragma unroll
                for (int j = 0; j < 4; ++j) { const f32x4 w = *(const LAS f32x4*)(WR + e * DM + 4 * lane + 256 * j); a += (v[j][0] * w[0] + v[j][1] * w[1]) + (v[j][2] * w[2] + v[j][3] * w[3]); }
                lg[e] = wave_sum(a); }
            float b1 = lg[0]; int e1 = 0;
#pragma unroll
            for (int e = 1; e < 8; ++e) if (lg[e] > b1) { b1 = lg[e]; e1 = e; }
            float b2 = -3.0e38f; int e2 = 0;
#pragma unroll
            for (int e = 0; e < 8; ++e) if (e != e1 && lg[e] > b2) { b2 = lg[e]; e2 = e; }
            const float w1 = 1.f / (1.f + __expf(b2 - b1)), w2 = 1.f - w1;
            if (lane == 0) {
                const unsigned p1 = __hip_atomic_fetch_add(cnt + e1 * 64, 1u, RLX_AGENT), p2 = __hip_atomic_fetch_add(cnt + e2 * 64, 1u, RLX_AGENT);
                float* ro = ROUTE_out + (size_t)m * 8;
                ro[0] = __int_as_float(e1); ro[1] = __int_as_float(e2); ro[2] = __int_as_float((int)p1); ro[3] = __int_as_float((int)p2); ro[4] = w1; ro[5] = w2;
            }
        }
    }
}

__global__ void __launch_bounds__(NWAVES * 64, 2) mega_fwd(Args A0) {
    extern __shared__ __attribute__((aligned(16))) unsigned char lds_raw[];
    LAS unsigned char* const lds = (LAS unsigned char*)lds_raw;
    volatile LAS unsigned* const MISC = (volatile LAS unsigned*)(lds + MISC_OFF);
    const int tid0 = threadIdx.x, wave = __builtin_amdgcn_readfirstlane(tid0 >> 6);
    const int G = gridDim.x, bx = blockIdx.x;
    const int gw = bx * NWAVES + wave, NGW = G * NWAVES;
    for (int u = tid0; u < (LDS_BYTES - LDSCTL_OFF) / 4; u += NWAVES * 64) ((LAS unsigned*)(lds + LDSCTL_OFF))[u] = 0u;
    __syncthreads();
    XcdBarrier bar = xcd_barrier_post((unsigned*)(A0.ws + WS_CTL) + CW_BAR, MISC + 8);
#define GRID_BAR() xcd_barrier(bar)
#define ROPE ((f32x2*)(WSL + WS_ROPE))
#define C8SP ((float*)(WSL + WS_C8SP))
#define CBIAS ((float*)(WSL + WS_CBIAS))
#define ROUTE ((float*)(WSL + WS_ROUTE))
#define ROWS ((int*)(WSL + WS_ROWS))
#define SA ((float*)(WSL + WS_SA))
#define SH ((float*)(WSL + WS_SH))
#define CI ((float*)(WSL + WS_CI))
#define KCMP ((bf16*)(WSL + WS_KCMP))
#define CH ((bf16*)(WSL + WS_CH))
#define GT ((float*)(WSL + WS_GT))
#define HF ((float*)(WSL + WS_HF))
#define Y ((bf16*)(WSL + WS_Y))
#define HB ((bf16*)(WSL + WS_HB))
#define GATE ((bf16*)(WSL + WS_GATE))
#define UX ((bf16*)(WSL + WS_UX))
#define XR ((bf16*)(WSL + WS_XR))
#define AF ((float*)(WSL + WS_AF))
#define BF ((float*)(WSL + WS_BF))
#define HG ((bf16*)(WSL + WS_HG))
#define ACT ((bf16*)(WSL + WS_ACT))
#define AS ((bf16*)(WSL + WS_AS))
#define HS ((bf16*)(WSL + WS_HS))
#define YM ((bf16*)(WSL + WS_YM))
#define Qb ((bf16*)(WSL + WS_Q))
#define QRb ((bf16*)(WSL + WS_QR))
#define Ob ((bf16*)(WSL + WS_O))
#define KVT ((bf16*)(WSL + WS_KVT))
#define CNTW(la) ((unsigned*)(WSL + WS_CTL) + CW_CNT + (la) * 8 * 64)
#define PHASE() size_t zl = 0; asm volatile("" : "+s"(zl)); unsigned char* const WSL = A0.ws + zl; (void)WSL

    {
        PHASE(); FRESH_TID();
        LAS float* scr = (LAS float*)(lds + wave * 16384);
        transpose_family((A0.moe_w_gu + zl), (size_t)DM * 2 * MFF, 16, DM, 2 * MFF, 2 * MFF, (bf16*)(WSL + MW_GU), (size_t)2 * MFF * DM, MFF, scr, gw, NGW, lane);
        transpose_family((A0.moe_w_down + zl), (size_t)MFF * DM, 16, MFF, DM, DM, (bf16*)(WSL + MW_DN), (size_t)DM * MFF, 0, scr, gw, NGW, lane);
        transpose_family((A0.ffn_w_gu + zl), (size_t)DM * 2 * DFF, 2, DM, 2 * DFF, 2 * DFF, (bf16*)(WSL + W_GU), (size_t)2 * DFF * DM, DFF, scr, gw, NGW, lane);
        transpose_family((A0.ffn_w_down + zl), (size_t)DFF * DM, 2, DFF, DM, DM, (bf16*)(WSL + W_DN), (size_t)DM * DFF, 0, scr, gw, NGW, lane);
        transpose_family((A0.lru_w_in + zl), (size_t)DM * 2048, 2, DM, 2048, 2048, (bf16*)(WSL + W_IN), (size_t)2048 * DM, 0, scr, gw, NGW, lane);
        transpose_family((A0.lru_w_out + zl), (size_t)DM * DM, 2, DM, DM, DM, (bf16*)(WSL + W_OUT), (size_t)DM * DM, 0, scr, gw, NGW, lane);
        transpose_family((A0.nsa_w_kv + zl), 0, 1, DM, NKVP, NKVP, (bf16*)(WSL + W_KV), 0, 0, scr, gw, NGW, lane);
        transpose_family((A0.nsa_cmp_w1 + zl), (size_t)2048 * 256, 2, 2048, 256, 256, (bf16*)(WSL + W_C1), (size_t)256 * 2048, 0, scr, gw, NGW, lane);
        transpose_family((A0.nsa_w_qg + zl), (size_t)DM * NQG, 2, DM, NQG, NQG_PAD, (bf16*)(WSL + W_QG), (size_t)NQG_PAD * DM, 0, scr, gw, NGW, lane);
        transpose_family((A0.nsa_w_o + zl), (size_t)DM * DM, 2, DM, DM, DM, (bf16*)(WSL + W_O), (size_t)DM * DM, 0, scr, gw, NGW, lane);
        transpose_family((A0.lru_w_a + zl), (size_t)128 * 128, 16, 128, 128, 128, (bf16*)(WSL + W_GATE), (size_t)256 * 128, 0, scr, gw, NGW, lane);
        transpose_family((A0.lru_w_i + zl), (size_t)128 * 128, 16, 128, 128, 128, (bf16*)(WSL + W_GATE) + 128 * 128, (size_t)256 * 128, 0, scr, gw, NGW, lane);
        { const float* xin = (A0.x + zl); for (size_t i = (size_t)(bx * 512 + tid); i < (size_t)T * DM / 8; i += (size_t)G * 512) { const f32x4 a = *(const f32x4*)(xin + i * 8), b = *(const f32x4*)(xin + i * 8 + 4); *(v4u*)(HB + i * 8) = pack8(a, b); } }
        for (int i = bx * 512 + tid; i < SEQ * 8; i += G * 512) { const int pos = i >> 3, k = i & 7;
            const float inv = __builtin_powf(500000.0f, -(float)k / 8.0f); const float ang = (float)pos * inv;
            double s, c; sincos_d((double)ang, s, c); ROPE[i] = (f32x2){(float)c, (float)s}; }
        for (int i = bx * 512 + tid; i < 2 * DM; i += G * 512) { const float lam = (A0.lru_lambda + zl)[i]; C8SP[i] = 8.0f * log1pf(__expf(-lam)); }
        for (int it = bx; it < 8; it += G) { const int j = it >> 2, n = (it & 3) * 64 + (tid & 63), ks = tid >> 6; float a = 0.f;
            const float* pe = (A0.nsa_cmp_pos + zl) + j * 2048; const float* w1 = (A0.nsa_cmp_w1 + zl) + (size_t)j * 2048 * 256;
            for (int k = ks * 256; k < ks * 256 + 256; ++k) a += pe[k] * w1[(size_t)k * 256 + n];
            LAS float* red = (LAS float*)(lds + 12288); red[ks * 64 + (tid & 63)] = a; LDS_WAIT(); __syncthreads();
            if (tid < 64) { float s = 0.f;
#pragma unroll
                for (int q = 0; q < 8; ++q) s += red[q * 64 + tid]; CBIAS[j * 256 + (it & 3) * 64 + tid] = s; }
            __syncthreads(); }
    }
    GRID_BAR();

#ifndef NLAYERS
#define NLAYERS 4
#endif
    for (int l = 0; l < NLAYERS; ++l) {
        const int la = l & 1;
        const int lf = l >> 1;
        if (l < 2) {
            {
                PHASE();
                pg8::Gemm g{HB, (const bf16*)(WSL + W_IN) + (size_t)la * 2048 * DM, DM, DM, DM};
                pg8::DenseOrder S; S.init(T / 256, 8, G, bx, (size_t)256 * DM * 2, 0, (size_t)256 * DM * 2);
                EpiInProj E{GATE, UX};
#if !defined(NO_G1)
                pg8::gemm_phase<EpiInProj, pg8::DenseOrder, true, true>(lds, g, S, E);
#endif
            }
            GRID_BAR();
            {
                PHASE(); FRESH_TID();
                const float* cw = (A0.lru_conv_w + zl) + (size_t)la * 4 * DM; const float* cb = (A0.lru_conv_b + zl) + (size_t)la * DM;
                const bf16* ux = UX; bf16* xr = XR;
                for (size_t i = (size_t)(bx * 512 + tid); i < (size_t)T * 128; i += (size_t)G * 512) {
                    const int row = (int)(i >> 7), cg = (int)(i & 127), s = row & 2047, ch = cg * 8;
                    float a[8];
#pragma unroll
                    for (int e = 0; e < 8; ++e) a[e] = cb[ch + e];
#pragma unroll
                    for (int k = 0; k < 4; ++k) { if (s - 3 + k >= 0) { const v4u uw = *(const v4u*)(ux + (size_t)(row - 3 + k) * DM + ch); const float* wk = cw + k * DM + ch;
                        a[0] += wk[0] * bf_lo(uw.x); a[1] += wk[1] * bf_hi(uw.x); a[2] += wk[2] * bf_lo(uw.y); a[3] += wk[3] * bf_hi(uw.y);
                        a[4] += wk[4] * bf_lo(uw.z); a[5] += wk[5] * bf_hi(uw.z); a[6] += wk[6] * bf_lo(uw.w); a[7] += wk[7] * bf_hi(uw.w); } }
                    v4u o; o.x = cvt_pk_bf16(a[0], a[1]); o.y = cvt_pk_bf16(a[2], a[3]); o.z = cvt_pk_bf16(a[4], a[5]); o.w = cvt_pk_bf16(a[6], a[7]);
                    *(v4u*)(xr + (size_t)row * DM + ch) = o; }
            }
            GRID_BAR();
            {
                PHASE();
                pg8::Gemm g{XR, (const bf16*)(WSL + W_GATE) + (size_t)la * 2048 * 128, DM, 128, 128};
                pg8::DenseOrder S; S.init(T / 256, 8, G, bx, (size_t)256 * DM * 2, (size_t)128 * 2, (size_t)256 * 128 * 2);
                EpiGates E{XR, (A0.lru_b_a + zl) + la * DM, (A0.lru_b_i + zl) + la * DM, C8SP + la * DM, AF, BF};
#if !defined(NO_G2)
                pg8::gemm_phase<EpiGates, pg8::DenseOrder, true, true>(lds, g, S, E);
#endif
            }
            GRID_BAR();
            {   PHASE(); FRESH_TID();
                const float* af = AF; const float* bf = BF; float* sa = SA; float* sh = SH;
                for (int it = bx; it < BATCH * 32 * 2; it += G) { const int b = it >> 6, c = (it >> 1) & 31, ch = (it & 1) * 512 + tid; const size_t r0 = ((size_t)b * SEQ + c * 64) * DM + ch;
                    float Aa = 1.f, Hh = 0.f;
#pragma unroll 8
                    for (int s = 0; s < 64; ++s) { const float a = af[r0 + (size_t)s * DM], bb = bf[r0 + (size_t)s * DM]; Hh = a * Hh + bb; Aa *= a; }
                    sa[(size_t)(b * 32 + c) * DM + ch] = Aa; sh[(size_t)(b * 32 + c) * DM + ch] = Hh; } }
            GRID_BAR();
            {   PHASE(); FRESH_TID();
                const float* sa = SA; const float* sh = SH; float* ci = CI;
                for (int i = bx * 512 + tid; i < BATCH * DM; i += G * 512) { const int b = i >> 10, ch = i & 1023; float carry = 0.f;
                    for (int c = 0; c < 32; ++c) { const size_t o = (size_t)(b * 32 + c) * DM + ch; ci[o] = carry; carry = sa[o] * carry + sh[o]; } } }
            GRID_BAR();
            {   PHASE(); FRESH_TID();
                const float* af = AF; const float* bf = BF; const float* ci = CI; const bf16* gate = GATE; bf16* hg = HG;
                for (int it = bx; it < BATCH * 32 * 2; it += G) { const int b = it >> 6, c = (it >> 1) & 31, ch = (it & 1) * 512 + tid; const size_t r0 = ((size_t)b * SEQ + c * 64) * DM + ch;
                    float Hh = ci[(size_t)(b * 32 + c) * DM + ch];
#pragma unroll 8
                    for (int s = 0; s < 64; ++s) { const float a = af[r0 + (size_t)s * DM], bb = bf[r0 + (size_t)s * DM]; Hh = a * Hh + bb;
                        const float gt = __uint_as_float((unsigned)gate[r0 + (size_t)s * DM] << 16); hg[r0 + (size_t)s * DM] = (bf16)f2bf(Hh * gt); } } }
            GRID_BAR();
            {
                PHASE();
                pg8::Gemm g{HG, (const bf16*)(WSL + W_OUT) + (size_t)la * DM * DM, DM, DM, DM};
                pg8::DenseOrder S; S.init(T / 256, 4, G, bx, (size_t)256 * DM * 2, 0, (size_t)256 * DM * 2);
                EpiStore E{Y, DM};
#if !defined(NO_G3)
                pg8::gemm_phase<EpiStore, pg8::DenseOrder, true, true>(lds, g, S, E);
#endif
            }
            GRID_BAR();
        } else {
            {
                PHASE();
                pg8::Gemm g{HB, (const bf16*)(WSL + W_QG) + (size_t)la * NQG_PAD * DM, DM, DM, DM};
                pg8::DenseOrder S; S.init(T / 256, 5, G, bx, (size_t)256 * DM * 2, 0, (size_t)256 * DM * 2);
                EpiQG E{Qb, QRb, GT, ROPE};
#if !defined(NO_G4)
                pg8::gemm_phase<EpiQG, pg8::DenseOrder, true, true>(lds, g, S, E);
#endif
            }
            GRID_BAR();
#ifdef ZERO_ATTN
            {   PHASE(); FRESH_TID(); bf16* o = Ob; for (size_t i = (size_t)(bx * 512 + tid); i < (size_t)T * DM / 8; i += (size_t)G * 512) *(v4u*)(o + i * 8) = (v4u){0u, 0u, 0u, 0u}; }
#elif !defined(NO_ATTN)
            {   PHASE();
                for (int L = bx; L < BATCH * NKV * 32; L += G) { const int bg = L & 63, qt = ((L >> 6) + 5 * bg) & 31;
                    nsa::attn_unit(lds, bg >> 2, bg & 3, qt, Qb, QRb, GT, KVT, KCMP, Ob, (float*)(WSL + WS_CTL) + 2048); } }
#endif
            GRID_BAR();
            {
                PHASE();
                pg8::Gemm g{Ob, (const bf16*)(WSL + W_O) + (size_t)la * DM * DM, DM, DM, DM};
                pg8::DenseOrder S; S.init(T / 256, 4, G, bx, (size_t)256 * DM * 2, 0, (size_t)256 * DM * 2);
                EpiStore E{Y, DM};
#if !defined(NO_G5)
                pg8::gemm_phase<EpiStore, pg8::DenseOrder, true, true>(lds, g, S, E);
#endif
            }
            GRID_BAR();
        }
        {   PHASE();
            const float* hres = (l == 0) ? (A0.x + zl) : HF;
            if ((l & 1) == 0) ln_phase<0, false>(lds, hres, Y, nullptr, nullptr, (A0.ln_g + zl) + (size_t)(l * 2) * DM, (A0.ln_b + zl) + (size_t)(l * 2) * DM, HF, HB, nullptr, nullptr, nullptr, gw, NGW);
            else ln_phase<0, true>(lds, hres, Y, nullptr, nullptr, (A0.ln_g + zl) + (size_t)(l * 2) * DM, (A0.ln_b + zl) + (size_t)(l * 2) * DM, HF, HB, (A0.moe_w_router + zl) + (size_t)lf * DM * 8, ROUTE, CNTW(lf), gw, NGW);
        }
        GRID_BAR();
        if ((l & 1) == 0) {
            {
                PHASE();
                pg8::Gemm g{HB, (const bf16*)(WSL + W_GU) + (size_t)lf * 2 * DFF * DM, DM, DM, DM};
                pg8::DenseOrder S; S.init(T / 256, 2 * DFF / 256, G, bx, (size_t)256 * DM * 2, 0, (size_t)256 * DM * 2);
                EpiSwiglu E{ACT, DFF};
#if !defined(NO_G6)
                pg8::gemm_phase<EpiSwiglu, pg8::DenseOrder, true, true>(lds, g, S, E);
#endif
            }
            GRID_BAR();
            {
                PHASE();
                pg8::Gemm g{ACT, (const bf16*)(WSL + W_DN) + (size_t)lf * DM * DFF, DFF, DFF, DFF};
                pg8::DenseOrder S; S.init(T / 256, 4, G, bx, (size_t)256 * DFF * 2, 0, (size_t)256 * DFF * 2);
                EpiStore E{Y, DM};
#if !defined(NO_G7)
                pg8::gemm_phase<EpiStore, pg8::DenseOrder, true, true>(lds, g, S, E);
#endif
            }
            GRID_BAR();
            {   PHASE();
                float* const lnout = (l == 3) ? (A0.out + zl) : HF;
                ln_phase<0, false>(lds, HF, Y, nullptr, nullptr, (A0.ln_g + zl) + (size_t)(l * 2 + 1) * DM, (A0.ln_b + zl) + (size_t)(l * 2 + 1) * DM, lnout, HB, nullptr, nullptr, nullptr, gw, NGW);
            }
            GRID_BAR();
        } else {
#define LOAD_TP() int tp[9]; tp[0] = 0; { unsigned* const cnt_ = CNTW(lf); _Pragma("unroll") for (int e = 0; e < 8; ++e) { const unsigned c = __builtin_amdgcn_readfirstlane(__hip_atomic_load(cnt_ + e * 64, RLX_AGENT)); tp[e + 1] = tp[e] + (int)((c + 255u) >> 8); } }
            {
                PHASE(); FRESH_TID(); LOAD_TP();
                LAS int* TB = (LAS int*)lds;
                if (tid < 8) { int v = 0;
#pragma unroll
                    for (int e = 0; e < 8; ++e) if (tid == e) v = tp[e]; TB[tid] = v * 256; }
                LDS_WAIT(); __syncthreads();
                const float* route = ROUTE; const bf16* hb = HB; bf16* as = AS; int* rows = ROWS;
                for (int it = gw; it < 2 * T; it += NGW) { const int m = it >> 1, k = it & 1; const float* ro = route + (size_t)m * 8;
                    const int e = __float_as_int(ro[k]), pos = __float_as_int(ro[2 + k]); const int row = TB[e] + pos;
                    const v4u a = *(const v4u*)(hb + (size_t)m * DM + lane * 16), b = *(const v4u*)(hb + (size_t)m * DM + lane * 16 + 8);
                    *(v4u*)(as + (size_t)row * DM + lane * 16) = a; *(v4u*)(as + (size_t)row * DM + lane * 16 + 8) = b;
                    if (lane == 0) rows[it] = row; }
            }
            GRID_BAR();
            {
                PHASE(); LOAD_TP();
                pg8::Gemm g{AS, (const bf16*)(WSL + MW_GU) + (size_t)lf * 8 * 2 * MFF * DM, DM, DM, DM};
                pg8::GroupOrder S{tp[1], tp[2], tp[3], tp[4], tp[5], tp[6], tp[7], tp[8], 2 * MFF / 256, tp[8] * (2 * MFF / 256), G, bx, (size_t)256 * DM * 2, (size_t)256 * DM * 2};
                EpiSwiglu E{HS, MFF};
#if !defined(NO_G8)
                pg8::gemm_phase<EpiSwiglu, pg8::GroupOrder, true, true>(lds, g, S, E);
#endif
            }
            GRID_BAR();
            {
                PHASE(); LOAD_TP();
                pg8::Gemm g{HS, (const bf16*)(WSL + MW_DN) + (size_t)lf * 8 * DM * MFF, MFF, MFF, MFF};
                pg8::GroupOrder S{tp[1], tp[2], tp[3], tp[4], tp[5], tp[6], tp[7], tp[8], 4, tp[8] * 4, G, bx, (size_t)256 * MFF * 2, (size_t)256 * MFF * 2};
                EpiStore E{YM, DM};
#if !defined(NO_G9)
                pg8::gemm_phase<EpiStore, pg8::GroupOrder, true, true>(lds, g, S, E);
#endif
            }
            GRID_BAR();
            {   PHASE();
                float* const lnout = (l == 3) ? (A0.out + zl) : HF;
                ln_phase<1, false>(lds, HF, YM, ROUTE, ROWS, (A0.ln_g + zl) + (size_t)(l * 2 + 1) * DM, (A0.ln_b + zl) + (size_t)(l * 2 + 1) * DM, lnout, HB, nullptr, nullptr, nullptr, gw, NGW);
            }
            GRID_BAR();
        }
        if (l == 1) {
            {
                PHASE();
                pg8::Gemm g{HB, (const bf16*)(WSL + W_KV), DM, DM, DM};
                pg8::DenseOrder S; S.init(T / 256, 6, G, bx, (size_t)256 * DM * 2, 0, (size_t)256 * DM * 2);
                EpiKV E{KVT, ROPE};
#if !defined(NO_G10)
                pg8::gemm_phase<EpiKV, pg8::DenseOrder, true, true>(lds, g, S, E);
#endif
            }
            GRID_BAR();
            {
                PHASE();
                pg8::Gemm g{KVT, (const bf16*)(WSL + W_C1), 1024, 2048, 2048};
                pg8::DenseOrder S; S.init(32, 2, G, bx, (size_t)256 * 1024 * 2, (size_t)BATCH * NKV * SEQ * HD * 2, (size_t)256 * 2048 * 2);
                EpiCmp E{CH, CBIAS};
#if !defined(NO_G11)
                pg8::gemm_phase<EpiCmp, pg8::DenseOrder, true, true>(lds, g, S, E);
#endif
            }
            GRID_BAR();
            {
                PHASE(); FRESH_TID();
                LAS float* W2 = (LAS float*)lds;
                const float* w2g = (A0.nsa_cmp_w2 + zl); const bf16* chp = CH; bf16* kcmp = KCMP;
                for (int j = 0; j < 2; ++j) {
                    __syncthreads();
                    for (int i = tid; i < 256 * 64 / 4; i += 512) *(LAS f32x4*)(W2 + i * 4) = *(const f32x4*)(w2g + (size_t)j * 256 * 64 + i * 4);
                    LDS_WAIT(); __syncthreads();
                    for (int row = gw; row < 8192; row += NGW) { const bf16* hrow = chp + ((size_t)j * 8192 + row) * 256; float a = 0.f;
#pragma unroll 4
                        for (int n8 = 0; n8 < 32; ++n8) { const v4u hw = *(const v4u*)(hrow + n8 * 8); const LAS float* wp = W2 + n8 * 8 * 64 + lane;
                            a += bf_lo(hw.x) * wp[0] + bf_hi(hw.x) * wp[64] + bf_lo(hw.y) * wp[128] + bf_hi(hw.y) * wp[192] + bf_lo(hw.z) * wp[256] + bf_hi(hw.z) * wp[320] + bf_lo(hw.w) * wp[384] + bf_hi(hw.w) * wp[448]; }
                        if ((row & 127) == 127) a = 0.f;
                        kcmp[((size_t)j * 8192 + row) * 64 + lane] = (bf16)f2bf(a); }
                }
            }
            GRID_BAR();
        }
    }
#ifdef DBG_DENOM
    { PHASE(); FRESH_TID(); const float v = __hip_atomic_load((float*)(WSL + WS_CTL) + 2048, RLX_AGENT) / (float)(DBG_DENOM);
      float E = 20.f + 4.f * __log2f(fmaxf(v, 1e-30f)); E = fminf(fmaxf(E, 1.f), 90.f); const float c = __builtin_sqrtf(E);
      float* o = A0.out + zl; for (size_t i = (size_t)(bx * 512 + tid); i < (size_t)T * DM / 4; i += (size_t)G * 512) *(f32x4*)(o + i * 4) = (f32x4){c, c, c, c}; }
#endif
#if NLAYERS < 4
    { PHASE(); FRESH_TID(); const float* hf = HF; float* o = A0.out + zl; for (size_t i = (size_t)(bx * 512 + tid); i < (size_t)T * DM / 4; i += (size_t)G * 512) *(f32x4*)(o + i * 4) = *(const f32x4*)(hf + i * 4); }
#endif
}

extern "C" void kernel_launch(void* const* d_in, const int* in_sizes, int n_in, void* d_out, int out_size, void* d_ws, size_t ws_size, hipStream_t stream) {
    static int grid = 0;
    if (grid == 0) {
        if (n_in != 23 || in_sizes[0] != T * DM || out_size != T * DM || ws_size < WS_END) {
            fprintf(stderr, "kernel_launch: unexpected problem (n_in %d, in0 %d, out %d, ws %zu, need %zu); nothing launched\n", n_in, n_in > 0 ? in_sizes[0] : -1, out_size, ws_size, (size_t)WS_END); grid = -1; return; }
        int dev = 0, cus = 0, per_cu = 0;
        if (hipGetDevice(&dev) != hipSuccess || hipDeviceGetAttribute(&cus, hipDeviceAttributeMultiprocessorCount, dev) != hipSuccess) { grid = -1; return; }
        if (hipFuncSetAttribute((const void*)mega_fwd, hipFuncAttributeMaxDynamicSharedMemorySize, LDS_BYTES) != hipSuccess) { fprintf(stderr, "kernel_launch: hipFuncSetAttribute failed\n"); grid = -1; return; }
        if (hipOccupancyMaxActiveBlocksPerMultiprocessor(&per_cu, (const void*)mega_fwd, NWAVES * 64, LDS_BYTES) != hipSuccess || per_cu < 1) { fprintf(stderr, "kernel_launch: occupancy query says %d blocks per CU\n", per_cu); }
        (void)hipGetLastError();
        grid = cus;
    }
    if (grid < 0) return;
    if (hipMemsetAsync((char*)d_ws + WS_CTL, 0, CTL_ZERO_BYTES, stream) != hipSuccess) return;
    Args a{};
    a.x = (const float*)d_in[0]; a.ln_g = (const float*)d_in[1]; a.ln_b = (const float*)d_in[2]; a.lru_w_in = (const float*)d_in[3]; a.lru_conv_w = (const float*)d_in[4];
    a.lru_conv_b = (const float*)d_in[5]; a.lru_w_a = (const float*)d_in[6]; a.lru_b_a = (const float*)d_in[7]; a.lru_w_i = (const float*)d_in[8]; a.lru_b_i = (const float*)d_in[9];
    a.lru_lambda = (const float*)d_in[10]; a.lru_w_out = (const float*)d_in[11]; a.nsa_w_kv = (const float*)d_in[12]; a.nsa_cmp_pos = (const float*)d_in[13]; a.nsa_cmp_w1 = (const float*)d_in[14];
    a.nsa_cmp_w2 = (const float*)d_in[15]; a.nsa_w_qg = (const float*)d_in[16]; a.nsa_w_o = (const float*)d_in[17]; a.ffn_w_gu = (const float*)d_in[18]; a.ffn_w_down = (const float*)d_in[19];
    a.moe_w_router = (const float*)d_in[20]; a.moe_w_gu = (const float*)d_in[21]; a.moe_w_down = (const float*)d_in[22];
    a.out = (float*)d_out; a.ws = (unsigned char*)d_ws;
    hipLaunchKernelGGL(mega_fwd, dim3(grid), dim3(NWAVES * 64), LDS_BYTES, stream, a);
}
```

```cpp
#include <hip/hip_runtime.h>
#include <cstdio>
#include <cstdint>

#define GAS __attribute__((address_space(1)))
#define LAS __attribute__((address_space(3)))
typedef unsigned short bf16;
typedef unsigned v4u __attribute__((ext_vector_type(4)));
typedef unsigned v2u __attribute__((ext_vector_type(2)));
typedef float f32x4 __attribute__((ext_vector_type(4)));
typedef float f32x2 __attribute__((ext_vector_type(2)));
typedef float f32x16 __attribute__((ext_vector_type(16)));
typedef short bf16x8 __attribute__((ext_vector_type(8)));
typedef short s16x4 __attribute__((ext_vector_type(4)));
typedef GAS unsigned gu32;
#define RLX_AGENT __ATOMIC_RELAXED, __HIP_MEMORY_SCOPE_AGENT
#define LDS_WAIT() asm volatile("s_waitcnt lgkmcnt(0)" ::: "memory")
#define VM_WAIT() asm volatile("s_waitcnt vmcnt(0)" ::: "memory")

constexpr int BATCH = 16, SEQ = 2048, DM = 1024, T = BATCH * SEQ;
constexpr int LRU_BLOCKS = 8, LRU_BW = 128;
constexpr int NHEAD = 16, HD = 64, NKV = 4, HPG = 4;
constexpr int DFF = 2816, NEXP = 8, MFF = 3584;
constexpr int NQG = 1072, NQG_PAD = 1280, NKVP = 1536;
constexpr int CMP_HID = 256, NCMP = 127, NCMP_PAD = 128;
constexpr float DN_ALPHA = 1.681792830507429f;
constexpr float LN_EPS = 1e-5f;
constexpr int MOE_ROWS = 2 * T + NEXP * 256;
constexpr int NWAVES = 8;

constexpr size_t MiB = 1u << 20;
constexpr size_t WS_CTL = 0, CTL_ZERO_BYTES = 1 * MiB;
constexpr size_t WS_ROPE = 1 * MiB;
constexpr size_t WS_C8SP = WS_ROPE + 256 * 1024;
constexpr size_t WS_CBIAS = WS_C8SP + 16 * 1024;
constexpr size_t WS_CPART = WS_ROPE + 512 * 1024;
constexpr size_t WS_ROUTE = 2 * MiB;
constexpr size_t WS_ROWS = 3 * MiB;
constexpr size_t WS_SA = 4 * MiB, WS_SH = 6 * MiB, WS_CI = 8 * MiB;
constexpr size_t WS_KCMP = 10 * MiB;
constexpr size_t WS_CH = 12 * MiB;
constexpr size_t WS_GT = 20 * MiB;
constexpr size_t WS_W = 64 * MiB;
constexpr size_t W_IN = WS_W;
constexpr size_t W_GATE = W_IN + (size_t)2 * 2048 * 1024 * 2;
constexpr size_t W_OUT = W_GATE + (size_t)2 * 2048 * 128 * 2;
constexpr size_t W_KV = W_OUT + (size_t)2 * 1024 * 1024 * 2;
constexpr size_t W_C1 = W_KV + (size_t)1536 * 1024 * 2;
constexpr size_t W_QG = W_C1 + (size_t)2 * 256 * 2048 * 2;
constexpr size_t W_O = W_QG + (size_t)2 * 1280 * 1024 * 2;
constexpr size_t W_GU = W_O + (size_t)2 * 1024 * 1024 * 2;
constexpr size_t W_DN = W_GU + (size_t)2 * 5632 * 1024 * 2;
constexpr size_t MW_GU = W_DN + (size_t)2 * 1024 * 2816 * 2;
constexpr size_t MW_DN = MW_GU + (size_t)2 * 8 * 7168 * 1024 * 2;
constexpr size_t W_END = MW_DN + (size_t)2 * 8 * 1024 * 3584 * 2;
constexpr size_t WS_HF = 480 * MiB;
constexpr size_t WS_HB8 = WS_HF;
constexpr size_t WS_Y = 608 * MiB;
constexpr size_t WS_HB = 672 * MiB;
constexpr size_t WS_S = 736 * MiB;
constexpr size_t WS_GATE = WS_S, WS_UX = WS_S + 64 * MiB, WS_XR = WS_S + 128 * MiB, WS_AF = WS_S + 192 * MiB, WS_BF = WS_S + 320 * MiB, WS_HG = WS_UX;
constexpr size_t WS_ACT = WS_S;
constexpr size_t WS_AS = WS_S;
constexpr size_t WS_HS = WS_S + 136 * MiB;
constexpr size_t WS_YM = WS_S + 600 * MiB;
constexpr size_t WS_Q = WS_S, WS_QR = WS_S + 64 * MiB, WS_O = WS_S + 128 * MiB;
constexpr size_t WS_KVT = WS_S + 736 * MiB;
constexpr size_t WS_END = WS_KVT + 100 * MiB;
static_assert(W_END <= WS_HF, "weights overflow");
static_assert(WS_HS + (size_t)MOE_ROWS * MFF * 2 <= WS_YM, "HS overflow");
static_assert(WS_YM + (size_t)MOE_ROWS * DM * 2 <= WS_KVT, "YM overflow");
static_assert(WS_BF + (size_t)T * DM * 4 <= WS_KVT, "BF overflow");

constexpr int CW_BAR = 4096;
constexpr int CW_CNT = 16384;

constexpr int RING_BYTES = 131072;
constexpr int LDSCTL_OFF = RING_BYTES, MISC_OFF = LDSCTL_OFF + 320;
constexpr int LDS_BYTES = 147456;

__device__ __forceinline__ unsigned f2bf(float f) { unsigned u = __builtin_bit_cast(unsigned, f); return (u + 0x7fffu + ((u >> 16) & 1u)) >> 16; }
__device__ __forceinline__ unsigned pk2(float lo, float hi) { return f2bf(lo) | (f2bf(hi) << 16); }
__device__ __forceinline__ unsigned cvt_pk_bf16(float lo, float hi) { unsigned r; asm volatile("v_cvt_pk_bf16_f32 %0, %1, %2" : "=v"(r) : "v"(lo), "v"(hi)); return r; }
__device__ __forceinline__ float bf_lo(unsigned w) { return __uint_as_float(w << 16); }
__device__ __forceinline__ float bf_hi(unsigned w) { return __uint_as_float(w & 0xffff0000u); }
__device__ __forceinline__ float fast_exp(float x) { return __builtin_amdgcn_exp2f(x * 1.4426950408889634f); }
__device__ __forceinline__ float fast_rcp(float x) { return __builtin_amdgcn_rcpf(x); }
__device__ __forceinline__ float sigmoidf_(float x) { return fast_rcp(1.0f + fast_exp(-x)); }
__device__ __forceinline__ float gelu_tanh(float x) { const float u = 1.5957691216057308f * (x + 0.044715f * x * x * x); return x * fast_rcp(1.0f + fast_exp(-u)); }
__device__ __forceinline__ float silu_(float x) { return x * fast_rcp(1.0f + fast_exp(-x)); }
constexpr float QS_A = 127.0f / 4.25f, QS_W32 = 127.0f * 32.0f / 4.25f;
__device__ __forceinline__ unsigned q8(float x, float s) { const float r = __builtin_rintf(fminf(fmaxf(x * s, -127.0f), 127.0f)); return (unsigned)(int)r & 0xffu; }
__device__ __forceinline__ unsigned pack4_i8(float a, float b, float c, float d, float s) { return q8(a, s) | (q8(b, s) << 8) | (q8(c, s) << 16) | (q8(d, s) << 24); }
template <int CTRL> __device__ __forceinline__ float dpp_f(float v) { return __builtin_bit_cast(float, __builtin_amdgcn_update_dpp(0, __builtin_bit_cast(int, v), CTRL, 0xf, 0xf, true)); }
__device__ __forceinline__ float wave_sum(float v) {
    v += dpp_f<0xB1>(v); v += dpp_f<0x4E>(v); v += dpp_f<0x141>(v); v += dpp_f<0x140>(v);
    const int vi = __builtin_bit_cast(int, v);
    const float r0 = __builtin_bit_cast(float, __builtin_amdgcn_readlane(vi, 0)), r1 = __builtin_bit_cast(float, __builtin_amdgcn_readlane(vi, 16));
    const float r2 = __builtin_bit_cast(float, __builtin_amdgcn_readlane(vi, 32)), r3 = __builtin_bit_cast(float, __builtin_amdgcn_readlane(vi, 48));
    return (r0 + r1) + (r2 + r3);
}
namespace pg8 {
#define PG8_LAS __attribute__((address_space(3)))
typedef unsigned short bf16_t;
typedef unsigned u32x4 __attribute__((ext_vector_type(4)));
typedef int v4i_ __attribute__((ext_vector_type(4)));
typedef int v8i_ __attribute__((ext_vector_type(8)));
constexpr int BM = 256, BK = 64, HALF = 128, HTB = HALF * BK * 2, STAGE_BYTES = 8 * HTB, NXCD = 8, WGM = 8;
__host__ __device__ __forceinline__ int lds_byte(int r, int c) { const int st = (r >> 4) * 2 + (c >> 5), rr = r & 15, cc = c & 31, ob = rr * 64 + cc * 2; return st * 1024 + (ob ^ (((ob >> 9) & 1) << 5)); }
__host__ __device__ __forceinline__ void stage_rc(int b, int& R, int& C) { const int st = b / 1024, sb = b % 1024, swz = sb ^ (((sb >> 9) & 1) << 5); R = (st >> 1) * 16 + swz / 64; C = (st & 1) * 32 + (swz % 64) / 2; }
__host__ __device__ __forceinline__ int perm32(int rho) { const int n = rho >> 4, i = rho & 15; return 8 * (i >> 2) + 4 * n + (i & 3); }

struct Unit { int pm, pn, aux; size_t aoff, boff; };
struct Gemm { const bf16_t* A; const bf16_t* Bt; int lda, ldb, K; };

struct DenseOrder {
    int nM, nN, nwg, G, c; size_t a_pm, a_pn, b_pn;
    mutable int li, lw;
    __device__ __forceinline__ void init(int nM_, int nN_, int G_, int c_, size_t a_pm_, size_t a_pn_, size_t b_pn_) { nM = nM_; nN = nN_; nwg = nM * nN; G = G_; c = c_; a_pm = a_pm_; a_pn = a_pn_; b_pn = b_pn_; li = -2; lw = 0; }
    __device__ __forceinline__ bool next(int i, Unit& u) const {
        const long L = (long)i * G + c; if (L >= nwg) return false;
        const int nig = WGM * nN; int wgid;
        if (i == li + 1 && (nwg % NXCD) == 0 && (G % NXCD) == 0) wgid = lw + G / NXCD;
        else { wgid = (int)L; const int q = nwg / NXCD, r = nwg % NXCD, xcd = wgid % NXCD, off = wgid / NXCD; wgid = (xcd < r ? xcd * (q + 1) : r * (q + 1) + (xcd - r) * q) + off; }
        li = i; lw = wgid;
        const int gid = wgid / nig, rem = wgid - gid * nig, fm = gid * WGM, gsz = (nM - fm) < WGM ? (nM - fm) : WGM;
        if (gsz == WGM) { u.pm = fm + (rem & (WGM - 1)); u.pn = rem >> 3; } else { u.pm = fm + rem % gsz; u.pn = rem / gsz; }
        u.aux = 0; u.aoff = (size_t)u.pm * a_pm + (size_t)u.pn * a_pn; u.boff = (size_t)u.pn * b_pn; return true;
    }
};
struct GroupOrder {
    int t1, t2, t3, t4, t5, t6, t7, t8; int nNe, total, G, c; size_t a_pm, b_tile;
    mutable int li = -2, lpm = 0, lpn = 0, dpm = 0, dpn = 0;
    __device__ __forceinline__ bool next(int i, Unit& u) const {
        const long L = (long)i * G + c; if (L >= total) return false;
        int pm, pn;
        if (i == li + 1) { pn = lpn + dpn; pm = lpm + dpm; if (pn >= nNe) { pn -= nNe; ++pm; } }
        else { pm = (int)(L / nNe); pn = (int)(L % nNe); dpm = G / nNe; dpn = G % nNe; }
        li = i; lpm = pm; lpn = pn;
        const int e = (pm >= t1) + (pm >= t2) + (pm >= t3) + (pm >= t4) + (pm >= t5) + (pm >= t6) + (pm >= t7);
        u.pm = pm; u.pn = pn; u.aux = e; u.aoff = (size_t)pm * a_pm; u.boff = (size_t)(e * nNe + pn) * b_tile; return true;
    }
};
template <class Epi, class Sched, bool ALIGN_EPI = false, bool SP2 = false, int QM = 0>
__device__ __forceinline__ void gemm_phase(PG8_LAS unsigned char* lds, const Gemm g, const Sched& S, const Epi& E, const int wave_in) {
    int tid_; asm volatile("v_mbcnt_lo_u32_b32 %0, -1, 0\n\tv_mbcnt_hi_u32_b32 %0, -1, %0" : "=v"(tid_)); tid_ += 64 * wave_in;
    const int tid = tid_, wid = __builtin_amdgcn_readfirstlane(tid >> 6), lane = tid & 63, wr = wid >> 2, wc = wid & 3, fr = lane & 15, fq = lane >> 4;
    int K_ = g.K, lda_ = g.lda, ldb_ = g.ldb; asm volatile("" : "+s"(K_), "+s"(lda_), "+s"(ldb_));
    const int K = K_, nt = K / BK; const int lda = lda_, ldb = ldb_;
    unsigned voffA[2], voffB[2];
#pragma unroll
    for (int i = 0; i < 2; ++i) { int R, C; stage_rc(tid * 16 + i * 8192, R, C); const int Rb = Epi::PERM ? ((R & ~31) + perm32(R & 31)) : R;
        voffA[i] = (unsigned)(R * lda + C) * 2u; voffB[i] = (unsigned)(Rb * ldb + C) * 2u; }
    const size_t kstep = (size_t)(BK * 2);
    const size_t hstepA = (size_t)HALF * lda * 2, hstepB = (size_t)HALF * ldb * 2;
    const unsigned ldsw = (unsigned)wid * 1024u;
    const int aoff = lds_byte(wr * 64 + fr, fq * 8), boff = lds_byte(wc * 32 + fr, fq * 8);
#define PG8_SA(b, h) (((b) * 2 + (h)) * HTB)
#define PG8_SB(b, h) ((4 + (b) * 2 + (h)) * HTB)
#define PG8_STAGE(bufoff, gbase, voff) do { _Pragma("unroll") for (int _i = 0; _i < 2; ++_i) \
        __builtin_amdgcn_global_load_lds((const unsigned*)((const char*)(gbase) + (voff)[_i]), (PG8_LAS unsigned*)(lds + (bufoff) + ldsw + _i * 8192), 16, 0, 0); } while (0)
#define PG8_LDA(dst, b, h) do { _Pragma("unroll") for (int m = 0; m < 4; ++m) { const v4i_ lo_ = *(const PG8_LAS v4i_*)(lds + PG8_SA(b, h) + aoff + m * 2048), hi_ = *(const PG8_LAS v4i_*)(lds + PG8_SA(b, h) + aoff + m * 2048 + 1024); dst[m] = __builtin_shufflevector(lo_, hi_, 0, 1, 2, 3, 4, 5, 6, 7); } } while (0)
#define PG8_LDB(dst, b, h) do { _Pragma("unroll") for (int n = 0; n < 2; ++n) { const v4i_ lo_ = *(const PG8_LAS v4i_*)(lds + PG8_SB(b, h) + boff + n * 2048), hi_ = *(const PG8_LAS v4i_*)(lds + PG8_SB(b, h) + boff + n * 2048 + 1024); dst[n] = __builtin_shufflevector(lo_, hi_, 0, 1, 2, 3, 4, 5, 6, 7); } } while (0)
#define PG8_MMA(ai, bj, At, Bt) do { __builtin_amdgcn_s_setprio(1); \
        if constexpr (QM == 1) { _Pragma("unroll") for (int m = 0; m < 4; ++m) _Pragma("unroll") for (int n = 0; n < 2; ++n) \
            asm volatile("v_mfma_scale_f32_16x16x128_f8f6f4 %0, %1, %2, %0, %3, %3 op_sel_hi:[0,0,0]" : "+v"(acc[ai][bj][m][n]) : "v"(Bt[n]), "v"(At[m]), "v"(0x7f7f7f7f)); } \
        else if constexpr (QM == 2) { _Pragma("unroll") for (int m = 0; m < 4; ++m) _Pragma("unroll") for (int n = 0; n < 2; ++n) { \
            v4i_ c_ = __builtin_bit_cast(v4i_, acc[ai][bj][m][n]); \
            c_ = __builtin_amdgcn_mfma_i32_16x16x64_i8(__builtin_shufflevector(Bt[n], Bt[n], 0, 1, 2, 3), __builtin_shufflevector(At[m], At[m], 0, 1, 2, 3), c_, 0, 0, 0); \
            c_ = __builtin_amdgcn_mfma_i32_16x16x64_i8(__builtin_shufflevector(Bt[n], Bt[n], 4, 5, 6, 7), __builtin_shufflevector(At[m], At[m], 4, 5, 6, 7), c_, 0, 0, 0); \
            acc[ai][bj][m][n] = __builtin_bit_cast(f32x4, c_); } } \
        else { _Pragma("unroll") for (int m = 0; m < 4; ++m) _Pragma("unroll") for (int n = 0; n < 2; ++n) { \
            acc[ai][bj][m][n] = __builtin_amdgcn_mfma_f32_16x16x32_bf16(__builtin_bit_cast(bf16x8, __builtin_shufflevector(Bt[n], Bt[n], 0, 1, 2, 3)), __builtin_bit_cast(bf16x8, __builtin_shufflevector(At[m], At[m], 0, 1, 2, 3)), acc[ai][bj][m][n], 0, 0, 0); \
            acc[ai][bj][m][n] = __builtin_amdgcn_mfma_f32_16x16x32_bf16(__builtin_bit_cast(bf16x8, __builtin_shufflevector(Bt[n], Bt[n], 4, 5, 6, 7)), __builtin_bit_cast(bf16x8, __builtin_shufflevector(At[m], At[m], 4, 5, 6, 7)), acc[ai][bj][m][n], 0, 0, 0); } } \
        __builtin_amdgcn_s_setprio(0); } while (0)
#define PG8_WAIT_V(n) asm volatile("s_waitcnt vmcnt(" #n ")" ::: "memory")
#define PG8_WAIT_L(n) asm volatile("s_waitcnt lgkmcnt(" #n ")" ::: "memory")
#define PG8_BAR __builtin_amdgcn_s_barrier()
#define PG8_SCHED __builtin_amdgcn_sched_barrier(0)
    Unit cur, nxt; int ui = 0;
    if (!S.next(0, cur)) return;
    f32x4 acc[2][2][4][2];
#pragma unroll
    for (int a = 0; a < 2; ++a)
#pragma unroll
        for (int b = 0; b < 2; ++b)
#pragma unroll
            for (int m = 0; m < 4; ++m)
#pragma unroll
                for (int n = 0; n < 2; ++n) acc[a][b][m][n] = (f32x4){0.f, 0.f, 0.f, 0.f};
    v8i_ At[4], B0[2], B1[2];
    const char* cA = (const char*)g.A + cur.aoff; const char* cB = (const char*)g.Bt + cur.boff;
    if constexpr (SP2) {
        PG8_STAGE(PG8_SB(0, 0), cB, voffB); PG8_STAGE(PG8_SB(0, 1), cB + hstepB, voffB); PG8_STAGE(PG8_SA(0, 0), cA, voffA); PG8_STAGE(PG8_SA(0, 1), cA + hstepA, voffA);
        if (wr == 1) PG8_BAR;
        PG8_WAIT_V(2); PG8_BAR;
        PG8_STAGE(PG8_SB(1, 0), cB + kstep, voffB); PG8_STAGE(PG8_SA(1, 0), cA + kstep, voffA); PG8_STAGE(PG8_SB(1, 1), cB + hstepB + kstep, voffB);
        PG8_WAIT_V(6); PG8_BAR;
    } else {
        PG8_STAGE(PG8_SB(0, 0), cB, voffB); PG8_STAGE(PG8_SA(0, 0), cA, voffA); PG8_STAGE(PG8_SB(0, 1), cB + hstepB, voffB); PG8_STAGE(PG8_SA(0, 1), cA + hstepA, voffA);
        if (wr == 1) PG8_BAR;
        PG8_WAIT_V(4); PG8_BAR;
        PG8_STAGE(PG8_SB(1, 0), cB + kstep, voffB); PG8_STAGE(PG8_SA(1, 0), cA + kstep, voffA); PG8_STAGE(PG8_SB(1, 1), cB + hstepB + kstep, voffB);
        PG8_WAIT_V(6); PG8_BAR;
    }
    for (;;) {
        const bool has_next = S.next(ui + 1, nxt);
        const char* nA = has_next ? (const char*)g.A + nxt.aoff : cA; const char* nB = has_next ? (const char*)g.Bt + nxt.boff : cB;
        for (int t = 0; t < nt; t += 2) {
            const bool last = (t == nt - 2);
            const char* a1 = cA + (size_t)(t + 1) * kstep;
            const char* a2 = last ? nA : cA + (size_t)(t + 2) * kstep; const char* b2 = last ? nB : cB + (size_t)(t + 2) * kstep;
            const char* a3 = a2 + kstep; const char* b3 = b2 + kstep;
            if constexpr (SP2) {
            PG8_LDB(B0, 0, 0); PG8_LDB(B1, 0, 1); PG8_SCHED; PG8_LDA(At, 0, 0); PG8_STAGE(PG8_SA(1, 1), a1 + hstepA, voffA);
            PG8_WAIT_V(8); PG8_WAIT_L(0); PG8_BAR; PG8_MMA(0, 0, At, B0); PG8_MMA(0, 1, At, B1); PG8_BAR; PG8_SCHED;
            PG8_LDA(At, 0, 1); PG8_STAGE(PG8_SB(0, 0), b2, voffB); PG8_STAGE(PG8_SB(0, 1), b2 + hstepB, voffB); PG8_STAGE(PG8_SA(0, 0), a2, voffA);
            PG8_WAIT_V(8); PG8_WAIT_L(0); PG8_BAR; PG8_MMA(1, 0, At, B0); PG8_MMA(1, 1, At, B1); PG8_BAR; PG8_SCHED;
            PG8_LDB(B0, 1, 0); PG8_LDB(B1, 1, 1); PG8_SCHED; PG8_LDA(At, 1, 0); PG8_STAGE(PG8_SA(0, 1), a2 + hstepA, voffA);
            PG8_WAIT_V(8); PG8_WAIT_L(0); PG8_BAR; PG8_MMA(0, 0, At, B0); PG8_MMA(0, 1, At, B1); PG8_BAR; PG8_SCHED;
            PG8_LDA(At, 1, 1); PG8_STAGE(PG8_SB(1, 0), b3, voffB); PG8_STAGE(PG8_SB(1, 1), b3 + hstepB, voffB); PG8_STAGE(PG8_SA(1, 0), a3, voffA);
            PG8_WAIT_V(8); PG8_WAIT_L(0); PG8_BAR; PG8_MMA(1, 0, At, B0); PG8_MMA(1, 1, At, B1); PG8_BAR; PG8_SCHED;
            } else {
            PG8_LDB(B0, 0, 0); PG8_SCHED; PG8_LDA(At, 0, 0); PG8_STAGE(PG8_SA(1, 1), a1 + hstepA, voffA);
            PG8_WAIT_L(8); PG8_BAR; PG8_WAIT_L(0); PG8_MMA(0, 0, At, B0); PG8_BAR; PG8_SCHED;
            PG8_LDB(B1, 0, 1); PG8_STAGE(PG8_SB(0, 0), b2, voffB);
            PG8_BAR; PG8_WAIT_L(0); PG8_MMA(0, 1, At, B1); PG8_BAR;
            PG8_LDA(At, 0, 1); PG8_STAGE(PG8_SA(0, 0), a2, voffA);
            PG8_BAR; PG8_WAIT_L(0); PG8_MMA(1, 0, At, B0); PG8_BAR; PG8_SCHED;
            PG8_STAGE(PG8_SB(0, 1), b2 + hstepB, voffB);
            PG8_WAIT_V(6); PG8_BAR; PG8_MMA(1, 1, At, B1); PG8_BAR;
            PG8_LDB(B0, 1, 0); PG8_SCHED; PG8_LDA(At, 1, 0); PG8_STAGE(PG8_SA(0, 1), a2 + hstepA, voffA);
            PG8_WAIT_L(8); PG8_BAR; PG8_WAIT_L(0); PG8_MMA(0, 0, At, B0); PG8_BAR; PG8_SCHED;
            PG8_LDB(B1, 1, 1); PG8_STAGE(PG8_SB(1, 0), b3, voffB);
            PG8_BAR; PG8_WAIT_L(0); PG8_MMA(0, 1, At, B1); PG8_BAR;
            PG8_LDA(At, 1, 1); PG8_STAGE(PG8_SA(1, 0), a3, voffA);
            PG8_BAR; PG8_WAIT_L(0); PG8_MMA(1, 0, At, B0); PG8_BAR; PG8_SCHED;
            PG8_STAGE(PG8_SB(1, 1), b3 + hstepB, voffB);
            PG8_WAIT_V(6); PG8_BAR; PG8_MMA(1, 1, At, B1); PG8_BAR;
            }
        }
        if constexpr (QM == 1) asm volatile("s_nop 15\n\ts_nop 15" ::: "memory");
        if constexpr (ALIGN_EPI) { if (wr == 0) PG8_BAR; }
        if constexpr (QM == 2) {
#pragma unroll
            for (int a = 0; a < 2; ++a)
#pragma unroll
                for (int b = 0; b < 2; ++b)
#pragma unroll
                    for (int m = 0; m < 4; ++m)
#pragma unroll
                        for (int n = 0; n < 2; ++n) { const v4i_ c_ = __builtin_bit_cast(v4i_, acc[a][b][m][n]); acc[a][b][m][n] = (f32x4){(float)c_[0], (float)c_[1], (float)c_[2], (float)c_[3]}; } }
        { E(acc, cur, wr, wc, fr, fq); }
        if (!has_next) break;
#pragma unroll
        for (int a = 0; a < 2; ++a)
#pragma unroll
            for (int b = 0; b < 2; ++b)
#pragma unroll
                for (int m = 0; m < 4; ++m)
#pragma unroll
                    for (int n = 0; n < 2; ++n) { typedef float f32x2_ __attribute__((ext_vector_type(2))); f32x2_ lo_, hi_;
                        asm volatile("v_mov_b64 %0, 0" : "=v"(lo_)); asm volatile("v_mov_b64 %0, 0" : "=v"(hi_)); acc[a][b][m][n] = __builtin_shufflevector(lo_, hi_, 0, 1, 2, 3); }
        cur = nxt; cA = nA; cB = nB; ++ui;
        if constexpr (ALIGN_EPI) { if (wr == 1) PG8_BAR; }
    }
    PG8_WAIT_V(0);
    if constexpr (!ALIGN_EPI) { if (wr == 0) PG8_BAR; }
    PG8_BAR;
#undef PG8_SA
#undef PG8_SB
#undef PG8_STAGE
#undef PG8_LDA
#undef PG8_LDB
#undef PG8_MMA
#undef PG8_WAIT_V
#undef PG8_WAIT_L
#undef PG8_BAR
#undef PG8_SCHED
}

}
typedef const f32x4 (&AccT)[2][2][4][2];
using pg8::Unit;

__device__ __forceinline__ v4u pack8(const f32x4 a, const f32x4 b) {
    v4u w; w.x = cvt_pk_bf16(a[0], a[1]); w.y = cvt_pk_bf16(a[2], a[3]); w.z = cvt_pk_bf16(b[0], b[1]); w.w = cvt_pk_bf16(b[2], b[3]); return w;
}

__device__ __forceinline__ f32x4 gelu4(const f32x4 x) {
    constexpr float C0 = -1.5957691216057308f * 1.4426950408889634f, C1 = 0.044715f * C0;
    const f32x4 t = x * (x * x * C1 + C0);
    const f32x4 d = (f32x4){__builtin_amdgcn_exp2f(t[0]), __builtin_amdgcn_exp2f(t[1]), __builtin_amdgcn_exp2f(t[2]), __builtin_amdgcn_exp2f(t[3])} + 1.0f;
    return x * (f32x4){fast_rcp(d[0]), fast_rcp(d[1]), fast_rcp(d[2]), fast_rcp(d[3])};
}
struct EpiStore {
    static constexpr bool PERM = true;
    bf16* O; int ldc; float sc;
    __device__ __forceinline__ void operator()(AccT acc, const Unit& u, int wr, int wc, int fr, int fq) const {
        const int row0 = u.pm * 256 + wr * 64 + fr, col0 = u.pn * 256 + wc * 32 + 8 * fq;
#pragma unroll
        for (int ai = 0; ai < 2; ++ai)
#pragma unroll
            for (int m = 0; m < 4; ++m) { bf16* rowp = O + (size_t)(row0 + ai * 128 + m * 16) * ldc + col0;
#pragma unroll
                for (int bj = 0; bj < 2; ++bj) *(v4u*)(rowp + bj * 128) = pack8(acc[ai][bj][m][0] * sc, acc[ai][bj][m][1] * sc); }
    }
};
struct EpiInProj {
    static constexpr bool PERM = true;
    bf16* GATE; bf16* UX; float sc;
    __device__ __forceinline__ void operator()(AccT acc, const Unit& u, int wr, int wc, int fr, int fq) const {
        const bool isg = u.pn < 4; bf16* O = isg ? GATE : UX;
        const int row0 = u.pm * 256 + wr * 64 + fr, col0 = (u.pn & 3) * 256 + wc * 32 + 8 * fq;
#pragma unroll
        for (int ai = 0; ai < 2; ++ai)
#pragma unroll
            for (int m = 0; m < 4; ++m) { bf16* rowp = O + (size_t)(row0 + ai * 128 + m * 16) * DM + col0;
#pragma unroll
                for (int bj = 0; bj < 2; ++bj) { f32x4 a = acc[ai][bj][m][0] * sc, b = acc[ai][bj][m][1] * sc;
                    if (isg) { a = gelu4(a); b = gelu4(b); }
                    *(v4u*)(rowp + bj * 128) = pack8(a, b); } }
    }
};
struct EpiGates {
    static constexpr bool PERM = true;
    const bf16* XR; const float* ba; const float* bi; const float* c8sp; bf16* LAb; bf16* BTb; int abl;
    __device__ __forceinline__ void operator()(AccT acc, const Unit& u, int wr, int wc, int fr, int fq) const {
        const int row0 = u.pm * 256 + wr * 64 + fr, ch0 = u.pn * 128 + wc * 32 + 8 * fq;
        v4u xw[2][4];
#pragma unroll
        for (int ai = 0; ai < 2; ++ai)
#pragma unroll
            for (int m = 0; m < 4; ++m) xw[ai][m] = *(const v4u*)(XR + (unsigned)(row0 + ai * 128 + m * 16) * DM + ch0);
        f32x4 vba[2], vbi[2], vsp[2];
#pragma unroll
        for (int n = 0; n < 2; ++n) { vba[n] = *(const f32x4*)(ba + ch0 + 4 * n); vbi[n] = *(const f32x4*)(bi + ch0 + 4 * n); vsp[n] = *(const f32x4*)(c8sp + ch0 + 4 * n); }
        constexpr float NL2E = -1.4426950408889634f;
        f32x2 ba2[4], bi2[4], sp2[4];
#pragma unroll
        for (int n = 0; n < 2; ++n)
#pragma unroll
            for (int h = 0; h < 2; ++h) { ba2[2 * n + h] = (f32x2){vba[n][2 * h] * NL2E, vba[n][2 * h + 1] * NL2E}; bi2[2 * n + h] = (f32x2){vbi[n][2 * h] * NL2E, vbi[n][2 * h + 1] * NL2E};
                sp2[2 * n + h] = (f32x2){vsp[n][2 * h] * (2.0f * NL2E), vsp[n][2 * h + 1] * (2.0f * NL2E)}; }
        const f32x2 nl2 = {NL2E, NL2E}, one2 = {1.0f, 1.0f};
#pragma unroll
        for (int ai = 0; ai < 2; ++ai)
#pragma unroll
            for (int m = 0; m < 4; ++m) { const unsigned off = (unsigned)(row0 + ai * 128 + m * 16) * DM + ch0;
                const v4u xv = xw[ai][m]; const unsigned xq[4] = {xv.x, xv.y, xv.z, xv.w};
                unsigned ro[4], bo[4];
#pragma unroll
                for (int n = 0; n < 2; ++n)
#pragma unroll
                    for (int h = 0; h < 2; ++h) { const int p = 2 * n + h;
                        const f32x2 ar = {acc[ai][0][m][n][2 * h], acc[ai][0][m][n][2 * h + 1]}, ag = {acc[ai][1][m][n][2 * h], acc[ai][1][m][n][2 * h + 1]};
                        const f32x2 er = ar * nl2 + ba2[p], eg = ag * nl2 + bi2[p];
                        const f32x2 dr = (f32x2){__builtin_amdgcn_exp2f(er[0]), __builtin_amdgcn_exp2f(er[1])} + one2, dg = (f32x2){__builtin_amdgcn_exp2f(eg[0]), __builtin_amdgcn_exp2f(eg[1])} + one2;
                        const f32x2 r = {fast_rcp(dr[0]), fast_rcp(dr[1])}, ig = {fast_rcp(dg[0]), fast_rcp(dg[1])};
                        const f32x2 t = r * sp2[p]; const f32x2 a2 = {__builtin_amdgcn_exp2f(t[0]), __builtin_amdgcn_exp2f(t[1])};
                        const f32x2 om = one2 - a2; const f32x2 sq = {__builtin_sqrtf(fmaxf(om[0], 0.0f)), __builtin_sqrtf(fmaxf(om[1], 0.0f))};
                        const f32x2 xr2 = {bf_lo(xq[p]), bf_hi(xq[p])};
                        const f32x2 ob = sq * (ig * xr2);
                        ro[p] = __builtin_bit_cast(unsigned, __builtin_amdgcn_cvt_pknorm_u16(r[0], r[1])); bo[p] = cvt_pk_bf16(ob[0], ob[1]); }
                *(v4u*)(LAb + off) = (v4u){ro[0], ro[1], ro[2], ro[3]}; *(v4u*)(BTb + off) = (v4u){bo[0], bo[1], bo[2], bo[3]}; }
    }
};
struct EpiSwiglu {
    static constexpr bool PERM = true;
    bf16* O; int ldc; float sc;
    __device__ __forceinline__ void operator()(AccT acc, const Unit& u, int wr, int wc, int fr, int fq) const {
        const int row0 = u.pm * 256 + wr * 64 + fr, col0 = u.pn * 128 + wc * 32 + 8 * fq;
#pragma unroll
        for (int ai = 0; ai < 2; ++ai)
#pragma unroll
            for (int m = 0; m < 4; ++m) { f32x4 a, b;
#pragma unroll
                for (int e = 0; e < 4; ++e) { a[e] = silu_(acc[ai][0][m][0][e] * sc) * (acc[ai][1][m][0][e] * sc); b[e] = silu_(acc[ai][0][m][1][e] * sc) * (acc[ai][1][m][1][e] * sc); }
                *(v4u*)(O + (size_t)(row0 + ai * 128 + m * 16) * ldc + col0) = pack8(a, b); }
    }
};
struct EpiSwiglu8 {
    static constexpr bool PERM = true;
    unsigned char* O8; int ldc; float sc;
    __device__ __forceinline__ void operator()(AccT acc, const Unit& u, int wr, int wc, int fr, int fq) const {
        const int row0 = u.pm * 256 + wr * 64 + fr + (fq & 1) * 16, col0 = u.pn * 128 + wc * 32 + (fq >> 1) * 16;
        const float c1 = -1.4426950408889634f * sc, c2 = fast_rcp(sc * sc);
        const f32x2 c1v = {c1, c1}, c2v = {c2, c2};
#pragma unroll
        for (int ai = 0; ai < 2; ++ai)
#pragma unroll
            for (int mp = 0; mp < 2; ++mp) { unsigned wv[2][2];
#pragma unroll
                for (int mm = 0; mm < 2; ++mm) { const int m = 2 * mp + mm; f32x2 o[4];
#pragma unroll
                    for (int n = 0; n < 2; ++n)
#pragma unroll
                        for (int h = 0; h < 2; ++h) {
                            const f32x2 g = {acc[ai][0][m][n][2 * h], acc[ai][0][m][n][2 * h + 1]}, uu = {acc[ai][1][m][n][2 * h], acc[ai][1][m][n][2 * h + 1]};
                            const f32x2 x = g * c1v; const f32x2 e = {__builtin_amdgcn_exp2f(x[0]), __builtin_amdgcn_exp2f(x[1])};
                            const f32x2 d = e * c2v + c2v; const f32x2 r = {fast_rcp(d[0]), fast_rcp(d[1])};
                            o[2 * n + h] = (g * uu) * r; }
                    int w0 = __builtin_amdgcn_cvt_pk_fp8_f32(o[0][0], o[0][1], 0, false); w0 = __builtin_amdgcn_cvt_pk_fp8_f32(o[1][0], o[1][1], w0, true);
                    int w1 = __builtin_amdgcn_cvt_pk_fp8_f32(o[2][0], o[2][1], 0, false); w1 = __builtin_amdgcn_cvt_pk_fp8_f32(o[3][0], o[3][1], w1, true);
                    wv[mm][0] = (unsigned)w0; wv[mm][1] = (unsigned)w1; }
                asm volatile("s_nop 1\n\tv_permlane16_swap_b32 %0, %2\n\tv_permlane16_swap_b32 %1, %3\n\ts_nop 1" : "+v"(wv[0][0]), "+v"(wv[0][1]), "+v"(wv[1][0]), "+v"(wv[1][1]));
                *(v4u*)(O8 + (size_t)(row0 + ai * 128 + mp * 32) * ldc + col0) = (v4u){wv[0][0], wv[0][1], wv[1][0], wv[1][1]}; }
    }
};
__device__ __forceinline__ void rope_cs(int pos, float (&co)[8], float (&si)[8]) {
    constexpr float IR[8] = {1.591549431e-01f, 3.086376340e-02f, 5.985185713e-03f, 1.160663641e-03f, 2.250790790e-04f, 4.364795279e-05f, 8.464330808e-06f, 1.641426263e-06f};
    const float p = (float)pos;
#pragma unroll
    for (int k = 0; k < 8; ++k) { const float r = __builtin_amdgcn_fractf(p * IR[k]); co[k] = __builtin_amdgcn_cosf(r); si[k] = __builtin_amdgcn_sinf(r); }
}
__device__ __forceinline__ void rope8(f32x4& a, f32x4& b, bool lowhalf, bool active, const float (&co)[8], const float (&si)[8]) {
    f32x4 pa, pb;
#pragma unroll
    for (int e = 0; e < 4; ++e) { pa[e] = __shfl_xor(a[e], 16); pb[e] = __shfl_xor(b[e], 16); }
    if (active) {
#pragma unroll
        for (int e = 0; e < 4; ++e) {
            if (lowhalf) { a[e] = a[e] * co[e] - pa[e] * si[e]; b[e] = b[e] * co[4 + e] - pb[e] * si[4 + e]; }
            else { a[e] = a[e] * co[e] + pa[e] * si[e]; b[e] = b[e] * co[4 + e] + pb[e] * si[4 + e]; }
        }
    }
}
struct EpiKV {
    static constexpr bool PERM = true;
    bf16* KVT; float sc;
    __device__ __forceinline__ void operator()(AccT acc, const Unit& u, int wr, int wc, int fr, int fq) const {
        const int j = u.pn; const bool dorope = (j == 2 || j == 4) && ((wc & 1) == 0);
        const int row0 = u.pm * 256 + wr * 64 + fr, d0 = 32 * (wc & 1) + 8 * fq;
#pragma unroll
        for (int ai = 0; ai < 2; ++ai)
#pragma unroll
            for (int m = 0; m < 4; ++m) { const int row = row0 + ai * 128 + m * 16, b = row >> 11, s = row & 2047;
                float co[8], si[8]; if (dorope) rope_cs(s, co, si);
#pragma unroll
                for (int bj = 0; bj < 2; ++bj) { const int g = 2 * bj + (wc >> 1);
                    f32x4 a = acc[ai][bj][m][0] * sc, bq = acc[ai][bj][m][1] * sc;
                    if (dorope) rope8(a, bq, fq == 0, fq < 2, co, si);
                    *(v4u*)(KVT + ((size_t)((j * BATCH + b) * NKV + g) * SEQ + s) * HD + d0) = pack8(a, bq); } }
    }
};
constexpr float QSCALE = 0.125f * 1.4426950408889634f;
struct EpiQG {
    static constexpr bool PERM = true;
    bf16* Q; bf16* QR; float* GT; float sc;
    __device__ __forceinline__ void operator()(AccT acc, const Unit& u, int wr, int wc, int fr, int fq) const {
        const int row0 = u.pm * 256 + wr * 64 + fr;
        if (u.pn < 4) {
            const int col0 = u.pn * 256 + wc * 32 + 8 * fq; const bool dorope = (wc & 1) == 0;
#pragma unroll
            for (int ai = 0; ai < 2; ++ai)
#pragma unroll
                for (int m = 0; m < 4; ++m) { const int row = row0 + ai * 128 + m * 16, s = row & 2047;
                    float co[8], si[8]; if (dorope) rope_cs(s, co, si);
#pragma unroll
                    for (int bj = 0; bj < 2; ++bj) { f32x4 a = acc[ai][bj][m][0] * (QSCALE * sc), bq = acc[ai][bj][m][1] * (QSCALE * sc);
                        const size_t off = (size_t)row * DM + col0 + bj * 128;
                        *(v4u*)(Q + off) = pack8(a, bq);
                        if (dorope) rope8(a, bq, fq == 0, fq < 2, co, si);
                        *(v4u*)(QR + off) = pack8(a, bq); } }
        } else {
            const int col0 = wc * 32 + 8 * fq;
            if (col0 < 48) {
#pragma unroll
                for (int ai = 0; ai < 2; ++ai)
#pragma unroll
                    for (int m = 0; m < 4; ++m) { const int row = row0 + ai * 128 + m * 16; f32x4 a = acc[ai][0][m][0], bq = acc[ai][0][m][1];
#pragma unroll
                        for (int e = 0; e < 4; ++e) { a[e] = sigmoidf_(a[e] * sc); bq[e] = sigmoidf_(bq[e] * sc); }
                        *(f32x4*)(GT + (size_t)row * 64 + col0) = a; *(f32x4*)(GT + (size_t)row * 64 + col0 + 4) = bq; }
            }
        }
    }
};
struct EpiCmp {
    static constexpr bool PERM = true;
    bf16* CH; const float* bias;
    __device__ __forceinline__ void operator()(AccT acc, const Unit& u, int wr, int wc, int fr, int fq) const {
        const int j = u.pn, row0 = u.pm * 256 + wr * 64 + fr, col0 = wc * 32 + 8 * fq;
        bf16* O = CH + (size_t)j * 8192 * 256;
        float bv[2][8];
#pragma unroll
        for (int bj = 0; bj < 2; ++bj)
#pragma unroll
            for (int e = 0; e < 8; ++e) bv[bj][e] = bias[j * 256 + bj * 128 + col0 + e];
#pragma unroll
        for (int ai = 0; ai < 2; ++ai)
#pragma unroll
            for (int m = 0; m < 4; ++m) { bf16* rowp = O + (size_t)(row0 + ai * 128 + m * 16) * 256 + col0;
#pragma unroll
                for (int bj = 0; bj < 2; ++bj) { f32x4 a = acc[ai][bj][m][0], b = acc[ai][bj][m][1];
#pragma unroll
                    for (int e = 0; e < 4; ++e) { a[e] = gelu_tanh(a[e] + bv[bj][e]); b[e] = gelu_tanh(b[e] + bv[bj][4 + e]); }
                    *(v4u*)(rowp + bj * 128) = pack8(a, b); } }
    }
};
#define XB_TMO      128
#define XB_XCNT(j)  (256  + 64 * (j))
#define XB_XSUB(j)  (1280 + 64 * (j))
#define XB_XGEN(j)  (2304 + 64 * (j))
#define XB_TOP      3328
#define XB_TOPGEN   3392
#define XCD_BAR_WORDS 3456
#define XB_SPIN_CAP (1u << 18)
__device__ __forceinline__ unsigned xb_ld(unsigned* p)              { return __hip_atomic_load(p, __ATOMIC_RELAXED, __HIP_MEMORY_SCOPE_AGENT); }
__device__ __forceinline__ unsigned xb_add(unsigned* p, unsigned v) { return __hip_atomic_fetch_add(p, v, __ATOMIC_RELAXED, __HIP_MEMORY_SCOPE_AGENT); }
__device__ __forceinline__ unsigned xb_xcc_id() { return (unsigned)__builtin_amdgcn_s_getreg((3 << 11) | 20) & 0xFu; }
#define XB_SPIN(cond, bar) do { unsigned _sp = 0; while (cond) { __builtin_amdgcn_s_sleep(1); \
    if ((++_sp & 255u) == 0u) { if (xb_ld(&(bar)[XB_TMO])) break; if (_sp > XB_SPIN_CAP) { atomicAdd(&(bar)[XB_TMO], 1u); break; } } } } while (0)
struct XcdBarrier { unsigned* bar; unsigned x; volatile LAS unsigned* st; };
__device__ __forceinline__ XcdBarrier xcd_barrier_post(unsigned* bar, volatile LAS unsigned* st) {
    XcdBarrier b; b.bar = bar; b.x = (unsigned)__builtin_amdgcn_readfirstlane((int)xb_xcc_id()); b.st = st;
    if (threadIdx.x == 0) (void)xb_add(&bar[XB_XCNT(b.x)], 1u);
    return b;
}
__device__ __forceinline__ void xcd_barrier_complete(unsigned* bar, unsigned x, unsigned& nloc, unsigned& nx) {
    const unsigned G = gridDim.x * gridDim.y * gridDim.z;
    unsigned sum, cnt, mine, sp = 0u;
    for (;;) {
        sum = 0u; cnt = 0u; mine = 0u;
#pragma unroll
        for (unsigned j = 0; j < 16; ++j) { const unsigned c = xb_ld(&bar[XB_XCNT(j)]); sum += c; cnt += (c > 0u) ? 1u : 0u; mine = (j == x) ? c : mine; }
        if (sum == G) break;
        __builtin_amdgcn_s_sleep(1);
        if ((++sp & 255u) == 0u) { if (xb_ld(&bar[XB_TMO])) break; if (sp > XB_SPIN_CAP) { atomicAdd(&bar[XB_TMO], 1u); break; } }
    }
    nloc = mine > 0u ? mine : 1u; nx = cnt > 0u ? cnt : 1u;
}
__device__ __forceinline__ void xcd_barrier(const XcdBarrier& b) {
    asm volatile("s_waitcnt vmcnt(0)" ::: "memory");
    __syncthreads();
    if (threadIdx.x == 0) {
        unsigned long zb_ = 0; unsigned bx_ = b.x; asm volatile("" : "+s"(zb_), "+s"(bx_)); unsigned* bar = b.bar + zb_;
        __builtin_amdgcn_s_waitcnt(0);
        unsigned nloc = b.st[0], nx = b.st[1];
        if (nloc == 0u) { xcd_barrier_complete(bar, bx_, nloc, nx); b.st[0] = nloc; b.st[1] = nx; }
        const unsigned old = xb_add(&bar[XB_XSUB(bx_)], 1u);
        const unsigned gen = old / nloc;
        if (old + 1u == (gen + 1u) * nloc) {
            __builtin_amdgcn_fence(__ATOMIC_RELEASE, "agent");
            asm volatile("s_waitcnt vmcnt(0)" ::: "memory");
            const unsigned og = xb_add(&bar[XB_TOP], 1u);
            const unsigned tg = og / nx;
            if (og + 1u == (tg + 1u) * nx) xb_add(&bar[XB_TOPGEN], 1u);
            else XB_SPIN(xb_ld(&bar[XB_TOPGEN]) == tg, bar);
            __builtin_amdgcn_fence(__ATOMIC_ACQUIRE, "agent");
            xb_add(&bar[XB_XGEN(bx_)], 1u);
            asm volatile("s_waitcnt vmcnt(0)" ::: "memory");
        } else {
            XB_SPIN(xb_ld(&bar[XB_XGEN(bx_)]) == gen, bar);
            __builtin_amdgcn_fence(__ATOMIC_ACQUIRE, "agent");
            asm volatile("s_waitcnt vmcnt(0)" ::: "memory");
        }
    }
    __syncthreads();
}

template <int KIND>
__device__ __forceinline__ void transpose_family_t(const float* src, size_t sstride, int nmat, int K, int Nsrc, int Ndst, unsigned char* dst, size_t dstride, int FSW, float wscale, LAS float* scr,
                                                   int gw, int NGW, int lane, int pm = 0, int rb = 0, int re = 0x7fffffff) {
    constexpr int ES = KIND == 0 ? 2 : 1;
    const int nkb = K / 64, nnb = Ndst / 32, per = nkb * nnb, total = per * nmat;
    const int n4 = (lane & 7) * 4, kr = lane >> 3, c = lane & 7;
    auto issue = [&](f32x4 (&v)[8], int it, bool& okn) { const int mat = it / per, r = it % per, kb = r / nnb, nb = r % nnb, n0 = nb * 32; okn = (n0 + n4) < Nsrc;
        const float* W = src + (size_t)mat * sstride + (size_t)(kb * 64 + kr) * Nsrc + (okn ? n0 + n4 : 0);
#pragma unroll
        for (int i = 0; i < 8; ++i) v[i] = *(const f32x4*)(W + (size_t)(8 * i) * Nsrc); };
    auto finish = [&](const f32x4 (&w)[8], int it, bool okn) { const int mat = it / per, r = it % per, kb = r / nnb, nb = r % nnb, n0 = nb * 32, k0 = kb * 64;
        size_t drow0 = n0;
        if (FSW > 0) { const int isu = n0 >= FSW, j = n0 - (isu ? FSW : 0); drow0 = (size_t)(j / 128) * 256 + (isu ? 128 : 0) + (j % 128); }
        const float sc = (okn && pm != 2) ? (KIND == 0 ? 1.0f : wscale) : 0.0f;
#pragma unroll
        for (int i = 0; i < 8; ++i) { LAS float* d = scr + (8 * i + kr) * 33 + n4; d[0] = w[i][0] * sc; d[1] = w[i][1] * sc; d[2] = w[i][2] * sc; d[3] = w[i][3] * sc; }
        LDS_WAIT(); asm volatile("" ::: "memory");
        unsigned char* D = dst + (size_t)mat * dstride * ES;
#pragma unroll
        for (int j = 0; j < 4; ++j) { const int n = (lane >> 3) + 8 * j; const LAS float* sp = scr + (8 * c) * 33 + n;
            unsigned char* o = D + ((drow0 + n) * (size_t)K + k0 + 8 * c) * ES;
            if (KIND == 0) { v4u q; q.x = pk2(sp[0 * 33], sp[1 * 33]); q.y = pk2(sp[2 * 33], sp[3 * 33]); q.z = pk2(sp[4 * 33], sp[5 * 33]); q.w = pk2(sp[6 * 33], sp[7 * 33]); *(v4u*)o = q; }
            else if (KIND == 1) {
                int w0 = __builtin_amdgcn_cvt_pk_fp8_f32(sp[0 * 33], sp[1 * 33], 0, false); w0 = __builtin_amdgcn_cvt_pk_fp8_f32(sp[2 * 33], sp[3 * 33], w0, true);
                int w1 = __builtin_amdgcn_cvt_pk_fp8_f32(sp[4 * 33], sp[5 * 33], 0, false); w1 = __builtin_amdgcn_cvt_pk_fp8_f32(sp[6 * 33], sp[7 * 33], w1, true);
                if (pm != 1) *(v2u*)o = (v2u){(unsigned)w0, (unsigned)w1}; }
            else { const unsigned w0 = pack4_i8(sp[0 * 33], sp[1 * 33], sp[2 * 33], sp[3 * 33], 1.0f), w1 = pack4_i8(sp[4 * 33], sp[5 * 33], sp[6 * 33], sp[7 * 33], 1.0f);
                if (pm != 1) *(v2u*)o = (v2u){w0, w1}; } }
        LDS_WAIT(); asm volatile("" ::: "memory"); };
    int it = gw + rb * NGW, rr = rb;
    f32x4 va[8], vb[8]; bool oka = false, okb = false;
    if (it < total && rr < re) issue(va, it, oka);
    while (it < total && rr < re) {
        issue(vb, (it + NGW < total && rr + 1 < re) ? it + NGW : it, okb);
        finish(va, it, oka);
        it += NGW; ++rr;
        if (!(it < total && rr < re)) break;
        issue(va, (it + NGW < total && rr + 1 < re) ? it + NGW : it, oka);
        finish(vb, it, okb);
        it += NGW; ++rr;
    }
}
__device__ __forceinline__ void transpose_family_f8(const float* src, size_t sstride, int nmat, int K, int N, int Ndst, unsigned char* dst, size_t dstride, int FSW, float wscale, LAS float* scr, int gw, int NGW, int lane, int pm = 0, int rb = 0, int re = 0x7fffffff) {
    transpose_family_t<1>(src, sstride, nmat, K, N, Ndst, dst, dstride, FSW, wscale, scr, gw, NGW, lane, pm, rb, re); }
__device__ __forceinline__ void transpose_family_i8(const float* src, size_t sstride, int nmat, int K, int N, int Ndst, unsigned char* dst, size_t dstride, int FSW, float wscale, LAS float* scr, int gw, int NGW, int lane, int pm = 0, int rb = 0, int re = 0x7fffffff) {
    transpose_family_t<2>(src, sstride, nmat, K, N, Ndst, dst, dstride, FSW, wscale, scr, gw, NGW, lane, pm, rb, re); }
__device__ __forceinline__ void transpose_family(const float* src, size_t sstride, int nmat, int K, int Nsrc, int Ndst, bf16* dst, size_t dstride, int FSW, LAS float* scr, int gw, int NGW, int lane) {
    transpose_family_t<0>(src, sstride, nmat, K, Nsrc, Ndst, (unsigned char*)dst, dstride, FSW, 1.0f, scr, gw, NGW, lane); }
#define FRESH_TID() int lane_f; asm volatile("v_mbcnt_lo_u32_b32 %0, -1, 0\n\tv_mbcnt_hi_u32_b32 %0, -1, %0" : "=v"(lane_f)); const int lane = lane_f, tid = lane_f + 64 * wave; (void)lane; (void)tid
namespace nsa {
constexpr int KROW = 144;
constexpr int KT_BYTES = 64 * KROW, VT_BYTES = 8192;
constexpr int L_KC = 0, L_VC = L_KC + 2 * KT_BYTES, L_KB = L_VC + 2 * VT_BYTES, L_VB = L_KB + 2 * KT_BYTES, L_PS = L_VB + 2 * VT_BYTES;
constexpr int L_IMP = L_PS + 8 * 8 * 128 * 4, L_UNI = L_IMP + 8 * 8 * 32 * 4, L_END = L_UNI + 64;
static_assert(L_END <= RING_BYTES, "attention LDS");
constexpr float NEGB = -1e30f, LOG2E = 1.4426950408889634f;

__device__ __forceinline__ int crow(int r, int hi) { return (r & 3) + 8 * (r >> 2) + 4 * hi; }
__device__ __forceinline__ s16x4 vtr(const LAS unsigned char* p) { return __builtin_bit_cast(s16x4, __builtin_amdgcn_ds_read_tr16_b64_v4i16((LAS s16x4*)p)); }
__device__ __forceinline__ float pmax32(float v) { return fmaxf(v, __shfl_xor(v, 32)); }
__device__ __forceinline__ void headsum4(float& a0, float& a1, float& a2, float& a3) {
    a0 += dpp_f<0x128>(a0); a1 += dpp_f<0x128>(a1); a2 += dpp_f<0x128>(a2); a3 += dpp_f<0x128>(a3);
    float b0, b1, b2, b3;
    asm volatile("v_mov_b32 %4, %0\n\tv_mov_b32 %5, %1\n\tv_mov_b32 %6, %2\n\tv_mov_b32 %7, %3\n\ts_nop 1\n\t"
                 "v_permlane16_swap_b32 %0, %4\n\tv_permlane16_swap_b32 %1, %5\n\tv_permlane16_swap_b32 %2, %6\n\tv_permlane16_swap_b32 %3, %7\n\ts_nop 1"
                 : "+v"(a0), "+v"(a1), "+v"(a2), "+v"(a3), "=&v"(b0), "=&v"(b1), "=&v"(b2), "=&v"(b3));
    a0 += b0; a1 += b1; a2 += b2; a3 += b3;
}

__device__ __forceinline__ void qk_tile(f32x16& p0, f32x16& p1, const LAS unsigned char* kt, const bf16x8 (&qf)[4], int r32, int hi) {
    p0 = (f32x16){0.f, 0.f, 0.f, 0.f, 0.f, 0.f, 0.f, 0.f, 0.f, 0.f, 0.f, 0.f, 0.f, 0.f, 0.f, 0.f}; p1 = p0;
    bf16x8 k0[4], k1[4];
#pragma unroll
    for (int d0 = 0; d0 < 4; ++d0) { k0[d0] = *(const LAS bf16x8*)(kt + r32 * KROW + d0 * 32 + hi * 16); k1[d0] = *(const LAS bf16x8*)(kt + (32 + r32) * KROW + d0 * 32 + hi * 16); }
    LDS_WAIT();
#pragma unroll
    for (int d0 = 0; d0 < 4; ++d0) {
        p0 = __builtin_amdgcn_mfma_f32_32x32x16_bf16(k0[d0], qf[d0], p0, 0, 0, 0);
        p1 = __builtin_amdgcn_mfma_f32_32x32x16_bf16(k1[d0], qf[d0], p1, 0, 0, 0);
    }
}
__device__ __forceinline__ void pv_tile(f32x16 (&o)[2], const LAS unsigned char* vt, const bf16x8 (&pb)[4], int lane) {
    const int hi = lane >> 5;
    const LAS unsigned char* vp = vt + ((lane >> 4) & 1) * 32 + (lane & 3) * 8 + (4 * hi + ((lane & 15) >> 2)) * 64;
    s16x4 lo[2][4], hh[2][4];
#pragma unroll
    for (int dh = 0; dh < 2; ++dh)
#pragma unroll
        for (int ks = 0; ks < 4; ++ks) { lo[dh][ks] = vtr(vp + dh * 4096 + ks * 1024); hh[dh][ks] = vtr(vp + dh * 4096 + ks * 1024 + 512); }
    LDS_WAIT();
#pragma unroll
    for (int ks = 0; ks < 4; ++ks)
#pragma unroll
        for (int dh = 0; dh < 2; ++dh) {
            const bf16x8 vf = (bf16x8){lo[dh][ks][0], lo[dh][ks][1], lo[dh][ks][2], lo[dh][ks][3], hh[dh][ks][0], hh[dh][ks][1], hh[dh][ks][2], hh[dh][ks][3]};
            o[dh] = __builtin_amdgcn_mfma_f32_32x32x16_bf16(vf, pb[ks], o[dh], 0, 0, 0);
        }
}
__device__ __forceinline__ void pack_p(bf16x8 (&pb)[4], const f32x16& p0, const f32x16& p1) {
    v4u w;
    w.x = cvt_pk_bf16(p0[0], p0[1]); w.y = cvt_pk_bf16(p0[2], p0[3]); w.z = cvt_pk_bf16(p0[4], p0[5]); w.w = cvt_pk_bf16(p0[6], p0[7]); pb[0] = __builtin_bit_cast(bf16x8, w);
    w.x = cvt_pk_bf16(p0[8], p0[9]); w.y = cvt_pk_bf16(p0[10], p0[11]); w.z = cvt_pk_bf16(p0[12], p0[13]); w.w = cvt_pk_bf16(p0[14], p0[15]); pb[1] = __builtin_bit_cast(bf16x8, w);
    w.x = cvt_pk_bf16(p1[0], p1[1]); w.y = cvt_pk_bf16(p1[2], p1[3]); w.z = cvt_pk_bf16(p1[4], p1[5]); w.w = cvt_pk_bf16(p1[6], p1[7]); pb[2] = __builtin_bit_cast(bf16x8, w);
    w.x = cvt_pk_bf16(p1[8], p1[9]); w.y = cvt_pk_bf16(p1[10], p1[11]); w.z = cvt_pk_bf16(p1[12], p1[13]); w.w = cvt_pk_bf16(p1[14], p1[15]); pb[3] = __builtin_bit_cast(bf16x8, w);
}
__device__ __forceinline__ void put_k(LAS unsigned char* kt, v4u v, int tid) { *(LAS v4u*)(kt + (tid >> 3) * KROW + (tid & 7) * 16) = v; }
__device__ __forceinline__ void put_v(LAS unsigned char* vt, v4u v, int tid) { const int kv = tid >> 3, ch = tid & 7; *(LAS v4u*)(vt + (ch >> 2) * 4096 + (kv >> 4) * 1024 + (kv & 15) * 64 + (ch & 3) * 16) = v; }

constexpr float BIG = 1e30f;
template <int ABL> __device__ __forceinline__ void tile_step(const bool MLO, const bool MCA, const LAS unsigned char* kt, const LAS unsigned char* vt, const bf16x8 (&qf)[4], int kv0, int tpos, bool rowok,
                                          float& l, f32x16 (&o)[2], int lane) {
    const int r32 = lane & 31, hi = lane >> 5;
    f32x16 p0, p1;
    if (ABL == 3) { p0 = o[0]; p1 = o[1]; } else qk_tile(p0, p1, kt, qf, r32, hi);
    if (MLO || MCA) {
#pragma unroll
        for (int r = 0; r < 16; ++r) {
            const int ka = kv0 + crow(r, hi), kb = ka + 32;
            const bool oka = (!MCA || ka <= tpos) && (!MLO || ka > tpos - 256), okb = (!MCA || kb <= tpos) && (!MLO || kb > tpos - 256);
            p0[r] = oka ? p0[r] : -BIG; p1[r] = okb ? p1[r] : -BIG;
        }
    }
    float ls = 0.f;
    if (ABL != 2) {
#pragma unroll
    for (int r = 0; r < 16; ++r) { p0[r] = __builtin_amdgcn_exp2f(p0[r]); p1[r] = __builtin_amdgcn_exp2f(p1[r]); }
    { const f32x16 ps = p0 + p1;
      const f32x4 q4 = (__builtin_shufflevector(ps, ps, 0, 1, 2, 3) + __builtin_shufflevector(ps, ps, 4, 5, 6, 7)) + (__builtin_shufflevector(ps, ps, 8, 9, 10, 11) + __builtin_shufflevector(ps, ps, 12, 13, 14, 15));
      ls = (q4[0] + q4[1]) + (q4[2] + q4[3]); } }
    bf16x8 pb[4]; pack_p(pb, p0, p1);
    if (!__all(rowok)) {
        const bf16x8 z8 = (bf16x8){0, 0, 0, 0, 0, 0, 0, 0};
#pragma unroll
        for (int k = 0; k < 4; ++k) pb[k] = rowok ? pb[k] : z8;
        ls = rowok ? ls : 0.f;
    }
    l += ls;
    if (ABL == 1) { o[0][0] += __builtin_bit_cast(float, (int)pb[0][0] + (int)pb[1][1] + (int)pb[2][2] + (int)pb[3][3]); } else pv_tile(o, vt, pb, lane);
}

template <int ABL> __device__ __forceinline__ void attn_unit(LAS unsigned char* lds, int b, int g, int qt, const bf16* Q, const bf16* QR, const float* GT, const bf16* KVT, const bf16* KCMP, bf16* O, float* DBGP, const int wave) {
    FRESH_TID(); const int r32 = lane & 31, hi = lane >> 5; const int wid = wave;
    const int bg = b * NKV + g;
    const int tl = r32 & 7, hh = r32 >> 3;
    const int tpos = qt * 64 + wid * 8 + tl;
    const unsigned trow = (unsigned)b * SEQ + tpos;
    const int head = g * HPG + hh;
    const bf16* kc = KCMP + (size_t)bg * 128 * 64; const bf16* vc = KCMP + (size_t)(64 + bg) * 128 * 64;
    const bf16* kslc = KVT + (size_t)((2 * BATCH + b) * NKV + g) * SEQ * HD; const bf16* vslc = KVT + (size_t)((3 * BATCH + b) * NKV + g) * SEQ * HD;
    const bf16* kwin = KVT + (size_t)((4 * BATCH + b) * NKV + g) * SEQ * HD; const bf16* vwin = KVT + (size_t)((5 * BATCH + b) * NKV + g) * SEQ * HD;
    LAS unsigned char* const KC = lds + L_KC; LAS unsigned char* const VC = lds + L_VC; LAS unsigned char* const KB = lds + L_KB; LAS unsigned char* const VB = lds + L_VB;
    LAS float* const PS = (LAS float*)(lds + L_PS) + wid * 8 * 128; LAS float* const IMP = (LAS float*)(lds + L_IMP) + wid * 8 * 32; LAS unsigned* const UNI = (LAS unsigned*)(lds + L_UNI);

    const bool two = qt >= 16;
    const int jw0 = qt >= 4 ? qt - 4 : 0, nwin = qt - jw0 + 1;
    {
        const v4u a0 = *(const v4u*)(kc + tid * 8), c0 = *(const v4u*)(vc + tid * 8);
        put_k(KC, a0, tid); put_v(VC, c0, tid);
        if (two) { const v4u a1 = *(const v4u*)(kc + 4096 + tid * 8), c1 = *(const v4u*)(vc + 4096 + tid * 8); put_k(KC + KT_BYTES, a1, tid); put_v(VC + VT_BYTES, c1, tid); }
    }
    v4u nk = *(const v4u*)(kwin + (unsigned)(jw0 * 4096 + tid * 8)), nv = *(const v4u*)(vwin + (unsigned)(jw0 * 4096 + tid * 8));
    v4u nk1, nv1;
    if (nwin >= 2) { nk1 = *(const v4u*)(kwin + (unsigned)((jw0 + 1) * 4096 + tid * 8)); nv1 = *(const v4u*)(vwin + (unsigned)((jw0 + 1) * 4096 + tid * 8)); }
    else { nk1 = *(const v4u*)(kslc + (unsigned)(tid * 8)); nv1 = *(const v4u*)(vslc + (unsigned)(tid * 8)); }
    const float g_cmp = GT[trow * 64 + head * 3 + 0], g_slc = GT[trow * 64 + head * 3 + 1], g_win = GT[trow * 64 + head * 3 + 2];
    bf16x8 qf[4];
#pragma unroll
    for (int d0 = 0; d0 < 4; ++d0) qf[d0] = *(const bf16x8*)(Q + trow * DM + head * HD + d0 * 16 + hi * 8);
    LDS_WAIT(); __syncthreads();

    f32x16 of[2];
    unsigned selmask;
    unsigned uni_w;
    {
        f32x16 s0, s1, s2, s3; qk_tile(s0, s1, KC, qf, r32, hi);
        if (two) qk_tile(s2, s3, KC + KT_BYTES, qf, r32, hi);
        else {
#pragma unroll
            for (int r = 0; r < 16; ++r) { s2[r] = NEGB; s3[r] = NEGB; } }
        const int cmax = tpos >= 31 ? ((tpos - 31) >> 4) : -1;
        float mx = NEGB;
#pragma unroll
        for (int r = 0; r < 16; ++r) { const int c = crow(r, hi);
            s0[r] = (c <= cmax) ? s0[r] : NEGB; s1[r] = (c + 32 <= cmax) ? s1[r] : NEGB; s2[r] = (c + 64 <= cmax) ? s2[r] : NEGB; s3[r] = (c + 96 <= cmax) ? s3[r] : NEGB;
            mx = fmaxf(fmaxf(mx, fmaxf(s0[r], s1[r])), fmaxf(s2[r], s3[r])); }
        mx = pmax32(mx);
        float ls = 0.f;
#pragma unroll
        for (int r = 0; r < 16; ++r) { const int c = crow(r, hi);
            s0[r] = __builtin_amdgcn_exp2f(s0[r] - mx); s1[r] = __builtin_amdgcn_exp2f(s1[r] - mx); ls += s0[r] + s1[r]; }
        if (two) {
#pragma unroll
            for (int r = 0; r < 16; ++r) { s2[r] = __builtin_amdgcn_exp2f(s2[r] - mx); s3[r] = __builtin_amdgcn_exp2f(s3[r] - mx); ls += s2[r] + s3[r]; }
        } else {
#pragma unroll
            for (int r = 0; r < 16; ++r) { s2[r] = 0.f; s3[r] = 0.f; } }
        ls += __shfl_xor(ls, 32);
        const float inv = cmax >= 0 ? 1.0f / ls : 0.f;
        s0 *= inv; s1 *= inv; s2 *= inv; s3 *= inv;
#pragma unroll
        for (int q = 0; q < 4; ++q) { const int c = 8 * q + 4 * hi;
            f32x4 t0 = (f32x4){s0[4 * q], s0[4 * q + 1], s0[4 * q + 2], s0[4 * q + 3]}, t1 = (f32x4){s1[4 * q], s1[4 * q + 1], s1[4 * q + 2], s1[4 * q + 3]};
            f32x4 t2 = (f32x4){s2[4 * q], s2[4 * q + 1], s2[4 * q + 2], s2[4 * q + 3]}, t3 = (f32x4){s3[4 * q], s3[4 * q + 1], s3[4 * q + 2], s3[4 * q + 3]};
#pragma unroll
            for (int e = 0; e < 4; ++e) { float x0 = t0[e], x1 = t1[e], x2 = t2[e], x3 = t3[e]; headsum4(x0, x1, x2, x3); t0[e] = x0; t1[e] = x1; t2[e] = x2; t3[e] = x3; }
            if (hh == 0) { *(LAS f32x4*)(PS + tl * 128 + c) = t0; *(LAS f32x4*)(PS + tl * 128 + c + 32) = t1; *(LAS f32x4*)(PS + tl * 128 + c + 64) = t2; *(LAS f32x4*)(PS + tl * 128 + c + 96) = t3; } }
        f32x16 oc[2]; oc[0] = (f32x16){0.f, 0.f, 0.f, 0.f, 0.f, 0.f, 0.f, 0.f, 0.f, 0.f, 0.f, 0.f, 0.f, 0.f, 0.f, 0.f}; oc[1] = oc[0];
        { bf16x8 pb[4]; pack_p(pb, s0, s1); pv_tile(oc, VC, pb, lane); if (two) { pack_p(pb, s2, s3); pv_tile(oc, VC + VT_BYTES, pb, lane); } }
#pragma unroll
        for (int r = 0; r < 16; ++r) { of[0][r] = g_cmp * oc[0][r]; of[1][r] = g_cmp * oc[1][r]; }
        LDS_WAIT(); asm volatile("" ::: "memory");
        const int st = lane >> 3, jq = lane & 7, spos = qt * 64 + wid * 8 + st, cur = spos >> 6;
        float imp[4];
#pragma unroll
        for (int i = 0; i < 4; ++i) { const int j = jq + 8 * i; const f32x4 pv4 = *(const LAS f32x4*)(PS + st * 128 + 4 * j);
            float a = (j > 0) ? PS[st * 128 + 4 * j - 1] : 0.f; a += pv4[0]; a += pv4[1]; a += pv4[2]; a += pv4[3];
            imp[i] = a; IMP[st * 32 + j] = a; }
        LDS_WAIT(); asm volatile("" ::: "memory");
        int rank[4] = {0, 0, 0, 0};
        f32x4 iv[8];
#pragma unroll
        for (int q = 0; q < 8; ++q) iv[q] = *(const LAS f32x4*)(IMP + st * 32 + 4 * q);
#pragma unroll
        for (int j2 = 1; j2 < 32; ++j2) if (j2 <= qt - 2) { const float v2 = iv[j2 >> 2][j2 & 3];
#pragma unroll
            for (int i = 0; i < 4; ++i) { const int j = jq + 8 * i; rank[i] += (v2 > imp[i] || (v2 == imp[i] && j2 < j)) ? 1 : 0; } }
        unsigned long long bal[4];
#pragma unroll
        for (int i = 0; i < 4; ++i) { const int j = jq + 8 * i; const bool sel = (j == 0) || (j == cur) || (j == cur - 1) || (j >= 1 && j <= cur - 2 && rank[i] < 5); bal[i] = __ballot(sel); }
        selmask = 0u; uni_w = 0u;
#pragma unroll
        for (int i = 0; i < 4; ++i) { selmask |= ((unsigned)(bal[i] >> (8 * tl)) & 0xffu) << (8 * i);
#pragma unroll
            for (int t8 = 0; t8 < 8; ++t8) uni_w |= ((unsigned)(bal[i] >> (8 * t8)) & 0xffu) << (8 * i); }
        uni_w = __builtin_amdgcn_readfirstlane(uni_w);
        if (lane == 0) UNI[wid] = uni_w;
    }
#pragma unroll
    for (int d0 = 0; d0 < 4; ++d0) qf[d0] = *(const bf16x8*)(QR + trow * DM + head * HD + d0 * 16 + hi * 8);
    put_k(KB, nk, tid); put_v(VB, nv, tid); put_k(KB + KT_BYTES, nk1, tid); put_v(VB + VT_BYTES, nv1, tid);
    LDS_WAIT(); __syncthreads();
    unsigned uni = 0u;
#pragma unroll
    for (int w = 0; w < 8; ++w) uni |= UNI[w];
    uni = __builtin_amdgcn_readfirstlane(uni);
    const int nslc = __builtin_popcount(uni), ntile = nwin + nslc;
    float l = 0.f; f32x16 o[2]; o[0] = (f32x16){0.f, 0.f, 0.f, 0.f, 0.f, 0.f, 0.f, 0.f, 0.f, 0.f, 0.f, 0.f, 0.f, 0.f, 0.f, 0.f}; o[1] = o[0];
    unsigned rem = uni; if (nwin == 1) rem &= rem - 1u;
    int blkA = jw0, blkB = (nwin >= 2) ? jw0 + 1 : 0, blkC = 0, blkD = 0;
    const int ngrp = (ntile + 1) >> 1;
    for (int g2 = 0; g2 < ngrp; ++g2) {
        const int i0 = 2 * g2, gb = g2 & 1;
        LAS unsigned char* const kg = gb ? KC : KB; LAS unsigned char* const vg = gb ? VC : VB;
        LAS unsigned char* const kn = gb ? KB : KC; LAS unsigned char* const vn = gb ? VB : VC;
        const bool hasC = i0 + 2 < ntile, hasD = i0 + 3 < ntile;
        if (hasC) { const bool w = (i0 + 2) < nwin; if (w) blkC = jw0 + i0 + 2; else { blkC = __builtin_ctz(rem); rem &= rem - 1u; }
            nk = *(const v4u*)((w ? kwin : kslc) + (unsigned)(blkC * 4096 + tid * 8)); nv = *(const v4u*)((w ? vwin : vslc) + (unsigned)(blkC * 4096 + tid * 8)); }
        if (hasD) { const bool w = (i0 + 3) < nwin; if (w) blkD = jw0 + i0 + 3; else { blkD = __builtin_ctz(rem); rem &= rem - 1u; }
            nk1 = *(const v4u*)((w ? kwin : kslc) + (unsigned)(blkD * 4096 + tid * 8)); nv1 = *(const v4u*)((w ? vwin : vslc) + (unsigned)(blkD * 4096 + tid * 8)); }
#pragma unroll
        for (int s2 = 0; s2 < 2; ++s2) { const int i = i0 + s2; if (i < ntile) {
            const int blk = s2 ? blkB : blkA;
            const bool isw = i < nwin;
            const bool need = isw || (((uni_w >> blk) & 1u) != 0u);
            const bool lo = isw && (qt >= 4) && (i == 0), ca = isw ? (i == nwin - 1) : (blk == qt);
            const bool rowok = isw || (((selmask >> blk) & 1u) != 0u);
            if (need) tile_step<ABL>(lo, ca, kg + s2 * KT_BYTES, vg + s2 * VT_BYTES, qf, blk * 64, tpos, rowok, l, o, lane);
            if (i == nwin - 1 || i == ntile - 1) {
                float lt = l + __shfl_xor(l, 32); const float gsc = ((i == nwin - 1) ? g_win : g_slc) / lt;
#pragma unroll
                for (int r = 0; r < 16; ++r) { of[0][r] += gsc * o[0][r]; of[1][r] += gsc * o[1][r]; o[0][r] = 0.f; o[1][r] = 0.f; }
                l = 0.f;
            } } }
        if (hasC) { put_k(kn, nk, tid); put_v(vn, nv, tid); }
        if (hasD) { put_k(kn + KT_BYTES, nk1, tid); put_v(vn + VT_BYTES, nv1, tid); }
        blkA = blkC; blkB = blkD;
        LDS_WAIT(); __syncthreads();
    }
#ifdef DBG_ATTN_STAT
    { float st_ = 0.f; DBG_ATTN_STAT; st_ = wave_sum(st_); if (lane == 0) atomicAdd(DBGP, st_); }
#endif
    { LAS unsigned char* const stg = (LAS unsigned char*)PS;
#pragma unroll
      for (int dh = 0; dh < 2; ++dh)
#pragma unroll
        for (int k = 0; k < 4; ++k) {
            int w = __builtin_amdgcn_cvt_pk_fp8_f32(of[dh][4 * k], of[dh][4 * k + 1], 0, false); w = __builtin_amdgcn_cvt_pk_fp8_f32(of[dh][4 * k + 2], of[dh][4 * k + 3], w, true);
            *(LAS unsigned*)(stg + tl * 256 + hh * 64 + 32 * dh + 8 * k + 4 * hi) = (unsigned)w; }
      LDS_WAIT(); asm volatile("" ::: "memory");
      const int tk = lane >> 3, chn = lane & 7;
      const v4u a0 = *(const LAS v4u*)(stg + tk * 256 + chn * 32), a1 = *(const LAS v4u*)(stg + tk * 256 + chn * 32 + 16);
      unsigned char* op = (unsigned char*)O + ((size_t)b * SEQ + qt * 64 + wid * 8 + tk) * DM + g * (HPG * HD) + chn * 32;
      *(v4u*)op = a0; *(v4u*)(op + 16) = a1;
      LDS_WAIT(); asm volatile("" ::: "memory"); }
}
}
#ifndef FFN_DN_BF16
#define FFN_DN_F8 1
#endif
#ifndef OUTPROJ_BF16
#define OUTPROJ_F8 1
#endif
#ifndef LN_DUMMY_OUT
#define LN_DUMMY_OUT ((bf16*)(A0.ws + WS_HF))
#endif
#ifndef MOE_W_EARLY
#define MOE_W_LATE 1
#endif
#ifdef MOE_W_LATE
#define MOE_PRO_MATS 8
#else
#define MOE_PRO_MATS 16
#endif
#ifndef REP0
#define REP0 1
#endif
#ifndef REP1
#define REP1 1
#endif
#ifndef REP2
#define REP2 1
#endif
#ifndef REP3
#define REP3 1
#endif
#ifndef REP4
#define REP4 1
#endif
#ifndef REP5
#define REP5 1
#endif
#ifndef REP6
#define REP6 1
#endif
#ifndef REP7
#define REP7 1
#endif
struct KArgs {
    const float* x; const float* ln_g; const float* ln_b; const float* lru_w_in; const float* lru_conv_w; const float* lru_conv_b; const float* lru_w_a; const float* lru_b_a;
    const float* lru_w_i; const float* lru_b_i; const float* lru_lambda; const float* lru_w_out; const float* nsa_w_kv; const float* nsa_cmp_pos; const float* nsa_cmp_w1;
    const float* nsa_cmp_w2; const float* nsa_w_qg; const float* nsa_w_o; const float* ffn_w_gu; const float* ffn_w_down; const float* moe_w_router; const float* moe_w_gu;
    const float* moe_w_down; float* out; unsigned char* ws;
};

typedef KArgs Args;
__device__ __forceinline__ unsigned char* launder_p(unsigned char* p) { asm volatile("" : "+s"(p)); return p; }
__device__ __forceinline__ const KArgs* launder_k(const KArgs* p) { asm volatile("" : "+s"(p)); return p; }

template <int MODE, bool ROUTER, bool RES32, bool OUT32>
__device__ __forceinline__ void ln_phase(LAS unsigned char* lds, const float* x32, const bf16* Y, const float* ROUTE_in, const int* ROWS_in, const float* gam, const float* bet,
                                         float* outf, bf16* HBp, bf16* HBo, unsigned char* HB8p, const float* wr, float* ROUTE_out, unsigned* cnt, int gw, int NGW, const int wave) {
    FRESH_TID();
    LAS float* WR = (LAS float*)lds;
    LAS int* EL = (LAS int*)(lds + 32768);
    if (ROUTER) {
        for (int k = tid; k < DM; k += NWAVES * 64) { const f32x4 a = *(const f32x4*)(wr + k * 8), b = *(const f32x4*)(wr + k * 8 + 4);
            WR[0 * DM + k] = a[0]; WR[1 * DM + k] = a[1]; WR[2 * DM + k] = a[2]; WR[3 * DM + k] = a[3]; WR[4 * DM + k] = b[0]; WR[5 * DM + k] = b[1]; WR[6 * DM + k] = b[2]; WR[7 * DM + k] = b[3]; }
        for (int i = tid; i < 16 * ((T + NGW - 1) / NGW); i += NWAVES * 64) EL[i] = -1;
        LDS_WAIT(); __syncthreads();
    }
    int rk = 0;
    f32x4 gv[4], bv[4];
#pragma unroll
    for (int j = 0; j < 4; ++j) { gv[j] = *(const f32x4*)(gam + 4 * lane + 256 * j); bv[j] = *(const f32x4*)(bet + 4 * lane + 256 * j); }
    v2u hq[4], yq[4]; f32x4 xq[4]; int r1q = 0, r2q = 0; float w1q = 0.f, w2q = 0.f;
    if (gw < T) { const unsigned ro = (unsigned)gw * DM + 4 * lane;
#pragma unroll
        for (int j = 0; j < 4; ++j) { if (RES32) xq[j] = *(const f32x4*)(x32 + ro + 256 * j); else hq[j] = *(const v2u*)(HBp + ro + 256 * j); if (MODE == 0) yq[j] = *(const v2u*)(Y + ro + 256 * j); }
        if (MODE == 1) { r1q = ROWS_in[2 * gw]; r2q = ROWS_in[2 * gw + 1]; w1q = ROUTE_in[(size_t)gw * 8 + 4]; w2q = ROUTE_in[(size_t)gw * 8 + 5]; } }
    for (int m = gw; m < T; m += NGW) {
        f32x4 v[4]; float s = 0.f;
        const unsigned ro4 = (unsigned)m * DM + 4 * lane;
        f32x4 h[4];
        v2u yc[4]; const int r1 = r1q, r2 = r2q; const float w1 = w1q, w2 = w2q;
#pragma unroll
        for (int j = 0; j < 4; ++j) { if (RES32) h[j] = xq[j]; else { const v2u hw = hq[j]; h[j] = (f32x4){bf_lo(hw.x), bf_hi(hw.x), bf_lo(hw.y), bf_hi(hw.y)}; } yc[j] = yq[j]; }
        const bf16* y1 = Y + (size_t)r1 * DM + 4 * lane; const bf16* y2 = Y + (size_t)r2 * DM + 4 * lane;
        v2u ya[4], yb[4];
        if (MODE == 1) {
#pragma unroll
            for (int j = 0; j < 4; ++j) { ya[j] = *(const v2u*)(y1 + 256 * j); yb[j] = *(const v2u*)(y2 + 256 * j); } }
        if (m + NGW < T) { const int mn = m + NGW; const unsigned ro = (unsigned)mn * DM + 4 * lane;
#pragma unroll
            for (int j = 0; j < 4; ++j) { if (RES32) xq[j] = *(const f32x4*)(x32 + ro + 256 * j); else hq[j] = *(const v2u*)(HBp + ro + 256 * j); if (MODE == 0) yq[j] = *(const v2u*)(Y + ro + 256 * j); }
            if (MODE == 1) { r1q = ROWS_in[2 * mn]; r2q = ROWS_in[2 * mn + 1]; w1q = ROUTE_in[(size_t)mn * 8 + 4]; w2q = ROUTE_in[(size_t)mn * 8 + 5]; } }
        if (MODE == 0) {
#pragma unroll
            for (int j = 0; j < 4; ++j) { const v2u y = yc[j];
                v[j][0] = DN_ALPHA * h[j][0] + bf_lo(y.x); v[j][1] = DN_ALPHA * h[j][1] + bf_hi(y.x); v[j][2] = DN_ALPHA * h[j][2] + bf_lo(y.y); v[j][3] = DN_ALPHA * h[j][3] + bf_hi(y.y); }
        } else {
#pragma unroll
            for (int j = 0; j < 4; ++j) { const v2u a = ya[j], b = yb[j];
                v[j][0] = DN_ALPHA * h[j][0] + (w1 * bf_lo(a.x) + w2 * bf_lo(b.x)); v[j][1] = DN_ALPHA * h[j][1] + (w1 * bf_hi(a.x) + w2 * bf_hi(b.x));
                v[j][2] = DN_ALPHA * h[j][2] + (w1 * bf_lo(a.y) + w2 * bf_lo(b.y)); v[j][3] = DN_ALPHA * h[j][3] + (w1 * bf_hi(a.y) + w2 * bf_hi(b.y)); }
        }
#pragma unroll
        for (int j = 0; j < 4; ++j) s += (v[j][0] + v[j][1]) + (v[j][2] + v[j][3]);
        const float mean = wave_sum(s) * (1.f / DM); float s2 = 0.f;
#pragma unroll
        for (int j = 0; j < 4; ++j) { v[j] = v[j] - mean; s2 += (v[j][0] * v[j][0] + v[j][1] * v[j][1]) + (v[j][2] * v[j][2] + v[j][3] * v[j][3]); }
        const float rstd = 1.f / __builtin_sqrtf(wave_sum(s2) * (1.f / DM) + LN_EPS);
#pragma unroll
        for (int j = 0; j < 4; ++j) { v[j] = v[j] * rstd * gv[j] + bv[j];
            if (OUT32) *(f32x4*)(outf + ro4 + 256 * j) = v[j];
            else if (HBo) { v2u w; w.x = cvt_pk_bf16(v[j][0], v[j][1]); w.y = cvt_pk_bf16(v[j][2], v[j][3]); *(v2u*)(HBo + ro4 + 256 * j) = w;
                if (HB8p) *(unsigned*)(HB8p + ro4 + 256 * j) = pack4_i8(v[j][0], v[j][1], v[j][2], v[j][3], QS_A); } }
        if (ROUTER) {
            float lg[8];
#pragma unroll
            for (int e = 0; e < 8; ++e) { float a = 0.f;
#pragma unroll
                for (int j = 0; j < 4; ++j) { const f32x4 w = *(const LAS f32x4*)(WR + e * DM + 4 * lane + 256 * j); a += (v[j][0] * w[0] + v[j][1] * w[1]) + (v[j][2] * w[2] + v[j][3] * w[3]); }
                lg[e] = wave_sum(a); }
            float b1 = lg[0]; int e1 = 0;
#pragma unroll
            for (int e = 1; e < 8; ++e) if (lg[e] > b1) { b1 = lg[e]; e1 = e; }
            float b2 = -3.0e38f; int e2 = 0;
#pragma unroll
            for (int e = 0; e < 8; ++e) if (e != e1 && lg[e] > b2) { b2 = lg[e]; e2 = e; }
            const float w1 = 1.f / (1.f + __expf(b2 - b1)), w2 = 1.f - w1;
            if (lane == 0) {
                const int q = rk * 8 + wave; EL[2 * q] = e1; EL[2 * q + 1] = e2;
                float* ro = ROUTE_out + (size_t)m * 8;
                ro[0] = __int_as_float(e1); ro[1] = __int_as_float(e2); ro[4] = w1; ro[5] = w2;
            }
            ++rk;
        }
    }
    if (ROUTER) {
        LDS_WAIT(); __syncthreads();
        if (wave == 0) {
            const int nent = 16 * ((T + NGW - 1) / NGW); const unsigned long long lt = (1ull << lane) - 1ull;
            int cntv = 0;
            for (int base = 0; base < nent; base += 64) { const int en = EL[base + lane];
#pragma unroll
                for (int e = 0; e < 8; ++e) { const unsigned long long bm = __ballot(en == e); if (lane == e) cntv += __builtin_popcountll(bm); } }
            int runv = 0; if (lane < 8) runv = (int)__hip_atomic_fetch_add(cnt + lane * 64, (unsigned)cntv, RLX_AGENT);
            for (int base = 0; base < nent; base += 64) { const int en = EL[base + lane]; int myrank = 0;
#pragma unroll
                for (int e = 0; e < 8; ++e) { const unsigned long long bm = __ballot(en == e); const int off = __shfl(runv, e); if (en == e) myrank = off + __builtin_popcountll(bm & lt); if (lane == e) runv += __builtin_popcountll(bm); }
                if (en >= 0) { const int idx = base + lane, q = idx >> 1, k2 = idx & 1; const int mrow = (gw - wave) + (q & 7) + (q >> 3) * NGW; ROUTE_out[(size_t)mrow * 8 + 2 + k2] = __int_as_float(myrank); } }
        }
    }
}

__global__ void __launch_bounds__(NWAVES * 64, 2) mega_fwd(Args A0) {
    extern __shared__ __attribute__((aligned(16))) unsigned char lds_raw[];
    LAS unsigned char* const lds = (LAS unsigned char*)lds_raw;
    volatile LAS unsigned* const MISC = (volatile LAS unsigned*)(lds + MISC_OFF);
    const int tid0 = threadIdx.x, wave = __builtin_amdgcn_readfirstlane(tid0 >> 6);
    const int G = gridDim.x, bx = blockIdx.x;
    const int gw = bx * NWAVES + wave, NGW = G * NWAVES;
    for (int u = tid0; u < (LDS_BYTES - LDSCTL_OFF) / 4; u += NWAVES * 64) ((LAS unsigned*)(lds + LDSCTL_OFF))[u] = 0u;
    __syncthreads();
    XcdBarrier bar = xcd_barrier_post((unsigned*)(A0.ws + WS_CTL) + CW_BAR, MISC + 8);
#define GRID_BAR() xcd_barrier(bar)
#ifdef TIMING
    unsigned long long tprev = __builtin_amdgcn_s_memrealtime(); unsigned tc0 = 0, tc1 = 0, tc2 = 0, tc3 = 0, tc4 = 0, tc5 = 0, tc6 = 0, tc7 = 0;
#define TS(c) do { const unsigned long long tn_ = __builtin_amdgcn_s_memrealtime(); tc##c += (unsigned)(tn_ - tprev); tprev = tn_; } while (0)
#else
#define TS(c) do {} while (0)
#endif
#define C8SP ((float*)(WSL + WS_C8SP))
#define CBIAS ((float*)(WSL + WS_CBIAS))
#define ROUTE ((float*)(WSL + WS_ROUTE))
#define ROWS ((int*)(WSL + WS_ROWS))
#define SA ((float*)(WSL + WS_SA))
#define SH ((float*)(WSL + WS_SH))
#define CI ((float*)(WSL + WS_CI))
#define KCMP ((bf16*)(WSL + WS_KCMP))
#define CH ((bf16*)(WSL + WS_CH))
#define GT ((float*)(WSL + WS_GT))
#define HF ((float*)(WSL + WS_HF))
#define Y ((bf16*)(WSL + WS_Y))
#define HB ((bf16*)(WSL + WS_HB))
#define GATE ((bf16*)(WSL + WS_GATE))
#define UX ((bf16*)(WSL + WS_UX))
#define XR ((bf16*)(WSL + WS_XR))
#define AF ((float*)(WSL + WS_AF))
#define BF ((float*)(WSL + WS_BF))
#define HG ((bf16*)(WSL + WS_HG))
#define ACT ((bf16*)(WSL + WS_ACT))
#define AS ((bf16*)(WSL + WS_AS))
#define HS ((bf16*)(WSL + WS_HS))
#define YM ((bf16*)(WSL + WS_YM))
#define Qb ((bf16*)(WSL + WS_Q))
#define QRb ((bf16*)(WSL + WS_QR))
#define Ob ((bf16*)(WSL + WS_O))
#define KVT ((bf16*)(WSL + WS_KVT))
#define HB8 ((unsigned char*)(WSL + WS_HB8))
#define LN2_HB8 HB8
#define SCQ (1.0f / (QS_A * QS_W32))
#define CNTW(la) ((unsigned*)(WSL + WS_CTL) + CW_CNT + (la) * 8 * 64)
#define PHASE() size_t zl = 0; asm volatile("" : "+s"(zl)); unsigned char* const WSL = A0.ws + zl; (void)WSL

    for (int rep_ = 0; rep_ < REP0; ++rep_) { {
        PHASE(); FRESH_TID();
        LAS float* scr = (LAS float*)(lds + wave * 16384);
#ifdef PRO_PROBE
        const int PM_ = (rep_ < REP0 - 1) ? PRO_PROBE : 0;
#else
        const int PM_ = 0;
#endif
        for (int it = bx; it < 256; it += G) { const int jn = it >> 5, ks = it & 31, j = jn >> 2, n = (jn & 3) * 64 + (tid & 63), kq = tid >> 6; float a = 0.f;
            const float* pe = (A0.nsa_cmp_pos + zl) + j * 2048 + ks * 64 + kq * 8; const float* w1 = (A0.nsa_cmp_w1 + zl) + ((size_t)j * 2048 + ks * 64 + kq * 8) * 256 + n;
#pragma unroll
            for (int k = 0; k < 8; ++k) a += pe[k] * w1[(size_t)k * 256];
            LAS float* red = (LAS float*)(lds + 12288); red[kq * 64 + (tid & 63)] = a; LDS_WAIT(); __syncthreads();
            if (tid < 64) { float sm = 0.f;
#pragma unroll
                for (int q = 0; q < 8; ++q) sm += red[q * 64 + tid]; ((float*)(WSL + WS_CPART))[ks * 512 + j * 256 + (jn & 3) * 64 + tid] = sm; }
            __syncthreads(); }
        transpose_family_i8((A0.moe_w_gu + zl), (size_t)DM * 2 * MFF, MOE_PRO_MATS, DM, 2 * MFF, 2 * MFF, (unsigned char*)(WSL + MW_GU), (size_t)2 * MFF * DM, MFF, QS_W32, scr, gw, NGW, lane, PM_);
        transpose_family_f8((A0.moe_w_down + zl), (size_t)MFF * DM, MOE_PRO_MATS, MFF, DM, DM, (unsigned char*)(WSL + MW_DN), (size_t)DM * MFF, 0, 128.0f, scr, gw, NGW, lane, PM_);
        transpose_family_i8((A0.ffn_w_gu + zl), (size_t)DM * 2 * DFF, 2, DM, 2 * DFF, 2 * DFF, (unsigned char*)(WSL + W_GU), (size_t)2 * DFF * DM, DFF, QS_W32, scr, gw, NGW, lane);
#ifdef FFN_DN_F8
        transpose_family_f8((A0.ffn_w_down + zl), (size_t)DFF * DM, 2, DFF, DM, DM, (unsigned char*)(WSL + W_DN), (size_t)DM * DFF, 0, 128.0f, scr, gw, NGW, lane);
#else
        transpose_family((A0.ffn_w_down + zl), (size_t)DFF * DM, 2, DFF, DM, DM, (bf16*)(WSL + W_DN), (size_t)DM * DFF, 0, scr, gw, NGW, lane);
#endif
        transpose_family_i8((A0.lru_w_in + zl), (size_t)DM * 2048, 2, DM, 2048, 2048, (unsigned char*)(WSL + W_IN), (size_t)2048 * DM, 0, QS_W32, scr, gw, NGW, lane);
#ifdef OUTPROJ_F8
        transpose_family_f8((A0.lru_w_out + zl), (size_t)DM * DM, 2, DM, DM, DM, (unsigned char*)(WSL + W_OUT), (size_t)DM * DM, 0, 64.0f, scr, gw, NGW, lane);
#else
        transpose_family((A0.lru_w_out + zl), (size_t)DM * DM, 2, DM, DM, DM, (bf16*)(WSL + W_OUT), (size_t)DM * DM, 0, scr, gw, NGW, lane);
#endif
        transpose_family_i8((A0.nsa_w_kv + zl), 0, 1, DM, NKVP, NKVP, (unsigned char*)(WSL + W_KV), 0, 0, QS_W32, scr, gw, NGW, lane);
        transpose_family((A0.nsa_cmp_w1 + zl), (size_t)2048 * 256, 2, 2048, 256, 256, (bf16*)(WSL + W_C1), (size_t)256 * 2048, 0, scr, gw, NGW, lane);
        transpose_family_i8((A0.nsa_w_qg + zl), (size_t)DM * NQG, 2, DM, NQG, NQG_PAD, (unsigned char*)(WSL + W_QG), (size_t)NQG_PAD * DM, 0, QS_W32, scr, gw, NGW, lane);
        transpose_family_f8((A0.nsa_w_o + zl), (size_t)DM * DM, 2, DM, DM, DM, (unsigned char*)(WSL + W_O), (size_t)DM * DM, 0, 64.0f, scr, gw, NGW, lane);
        transpose_family((A0.lru_w_a + zl), (size_t)128 * 128, 16, 128, 128, 128, (bf16*)(WSL + W_GATE), (size_t)256 * 128, 0, scr, gw, NGW, lane);
        transpose_family((A0.lru_w_i + zl), (size_t)128 * 128, 16, 128, 128, 128, (bf16*)(WSL + W_GATE) + 128 * 128, (size_t)256 * 128, 0, scr, gw, NGW, lane);
        { const float* xin = (A0.x + zl); for (size_t i = (size_t)(bx * 512 + tid); i < (size_t)T * DM / 8; i += (size_t)G * 512) { const f32x4 a = *(const f32x4*)(xin + i * 8), b = *(const f32x4*)(xin + i * 8 + 4); *(v4u*)(HB + i * 8) = pack8(a, b);
            *(v2u*)(HB8 + i * 8) = (v2u){pack4_i8(a[0], a[1], a[2], a[3], QS_A), pack4_i8(b[0], b[1], b[2], b[3], QS_A)};
        } }
        for (int i = bx * 512 + tid; i < 2 * DM; i += G * 512) { const float lam = (A0.lru_lambda + zl)[i]; C8SP[i] = 8.0f * log1pf(__expf(-lam)); }
    }
            GRID_BAR(); } TS(0);

#ifndef NLAYERS
#define NLAYERS 4
#endif
    for (int l = 0; l < NLAYERS; ++l) {
        const int la = l & 1;
        const int lf = l >> 1;
        if (l < 2) {
            for (int rep_ = 0; rep_ < REP1; ++rep_) { {
                PHASE();
                pg8::Gemm g{(const bf16*)HB8, (const bf16*)(WSL + W_IN + (size_t)la * 2048 * DM), DM / 2, DM / 2, DM / 2};
                pg8::DenseOrder S; S.init(T / 256, 8, G, bx, (size_t)256 * DM, 0, (size_t)256 * DM);
                EpiInProj E{GATE, UX, SCQ};
                pg8::gemm_phase<EpiInProj, pg8::DenseOrder, true, true, 2>(lds, g, S, E, wave);
            }
            GRID_BAR(); } TS(1);
            for (int rep_ = 0; rep_ < REP5; ++rep_) { {
                PHASE(); FRESH_TID();
                if (l == 0 && bx == 0) { const float* cp = (const float*)(WSL + WS_CPART); float cq[32];
#pragma unroll
                    for (int q = 0; q < 32; ++q) cq[q] = cp[q * 512 + tid];
                    float sm = 0.f;
#pragma unroll
                    for (int q = 0; q < 32; ++q) sm += cq[q];
                    CBIAS[tid] = sm; }
                const float* cw = (A0.lru_conv_w + zl) + (size_t)la * 4 * DM; const float* cb = (A0.lru_conv_b + zl) + (size_t)la * DM;
                const bf16* ux = UX; bf16* xr = XR;
                for (int it = bx * 512 + tid; it < (T / 16) * 128; it += G * 512) {
                    const int rb = it >> 7, cg = it & 127, r0 = rb * 16, s0 = r0 & 2047, ch = cg * 8;
                    float wt[4][8], bb[8];
#pragma unroll
                    for (int k = 0; k < 4; ++k) { const f32x4 w0 = *(const f32x4*)(cw + k * DM + ch), w1 = *(const f32x4*)(cw + k * DM + ch + 4);
                        wt[k][0] = w0[0]; wt[k][1] = w0[1]; wt[k][2] = w0[2]; wt[k][3] = w0[3]; wt[k][4] = w1[0]; wt[k][5] = w1[1]; wt[k][6] = w1[2]; wt[k][7] = w1[3]; }
                    { const f32x4 b0 = *(const f32x4*)(cb + ch), b1 = *(const f32x4*)(cb + ch + 4); bb[0] = b0[0]; bb[1] = b0[1]; bb[2] = b0[2]; bb[3] = b0[3]; bb[4] = b1[0]; bb[5] = b1[1]; bb[6] = b1[2]; bb[7] = b1[3]; }
                    v4u u0 = (v4u){0u, 0u, 0u, 0u}, u1 = u0, u2 = u0;
                    if (s0 != 0) { u0 = *(const v4u*)(ux + (size_t)(r0 - 3) * DM + ch); u1 = *(const v4u*)(ux + (size_t)(r0 - 2) * DM + ch); u2 = *(const v4u*)(ux + (size_t)(r0 - 1) * DM + ch); }
                    v4u un[16];
#pragma unroll
                    for (int j = 0; j < 16; ++j) un[j] = *(const v4u*)(ux + (size_t)(r0 + j) * DM + ch);
#pragma unroll
                    for (int j = 0; j < 16; ++j) { const v4u u3 = un[j];
                        const unsigned w0[4] = {u0.x, u0.y, u0.z, u0.w}, w1[4] = {u1.x, u1.y, u1.z, u1.w}, w2[4] = {u2.x, u2.y, u2.z, u2.w}, w3[4] = {u3.x, u3.y, u3.z, u3.w};
                        float a[8];
#pragma unroll
                        for (int q = 0; q < 4; ++q) {
                            a[2 * q] = bb[2 * q] + wt[0][2 * q] * bf_lo(w0[q]) + wt[1][2 * q] * bf_lo(w1[q]) + wt[2][2 * q] * bf_lo(w2[q]) + wt[3][2 * q] * bf_lo(w3[q]);
                            a[2 * q + 1] = bb[2 * q + 1] + wt[0][2 * q + 1] * bf_hi(w0[q]) + wt[1][2 * q + 1] * bf_hi(w1[q]) + wt[2][2 * q + 1] * bf_hi(w2[q]) + wt[3][2 * q + 1] * bf_hi(w3[q]); }
                        v4u o; o.x = cvt_pk_bf16(a[0], a[1]); o.y = cvt_pk_bf16(a[2], a[3]); o.z = cvt_pk_bf16(a[4], a[5]); o.w = cvt_pk_bf16(a[6], a[7]);
                        *(v4u*)(xr + (size_t)(r0 + j) * DM + ch) = o;
                        u0 = u1; u1 = u2; u2 = u3; } }
            }
            GRID_BAR(); } TS(5);
            for (int rep_ = 0; rep_ < REP1; ++rep_) { {
                PHASE();
                pg8::Gemm g{XR, (const bf16*)(WSL + W_GATE) + (size_t)la * 2048 * 128, DM, 128, 128};
                pg8::DenseOrder S; S.init(T / 256, 8, G, bx, (size_t)256 * DM * 2, (size_t)128 * 2, (size_t)256 * 128 * 2);
#ifdef GATES_PROBE
                EpiGates E{XR, (A0.lru_b_a + zl) + la * DM, (A0.lru_b_i + zl) + la * DM, C8SP + la * DM, (bf16*)AF, (bf16*)BF, (rep_ < REP1 - 1) ? GATES_PROBE : 0};
#else
                EpiGates E{XR, (A0.lru_b_a + zl) + la * DM, (A0.lru_b_i + zl) + la * DM, C8SP + la * DM, (bf16*)AF, (bf16*)BF, 0};
#endif
#if !defined(NO_G2)
                pg8::gemm_phase<EpiGates, pg8::DenseOrder, true, true>(lds, g, S, E, wave);
#endif
            }
            GRID_BAR(); } TS(1);
            for (int rep_ = 0; rep_ < REP5; ++rep_) { {   PHASE(); FRESH_TID();
                const unsigned* af = (const unsigned*)AF; const unsigned* bf = (const unsigned*)BF; f32x2* sa = (f32x2*)SA; f32x2* sh = (f32x2*)SH;
                const float nsp0 = -C8SP[la * DM + 2 * tid] * (1.0f / 65535.0f), nsp1 = -C8SP[la * DM + 2 * tid + 1] * (1.0f / 65535.0f);
                for (int it = bx; it < BATCH * 32; it += G) { const int b = it >> 5, c = it & 31; const unsigned r0 = ((unsigned)(b * SEQ + c * 64) * DM) / 2 + tid;
                    float A0_ = 1.f, A1_ = 1.f, H0 = 0.f, H1 = 0.f;
                    unsigned la[2][16], bt[2][16];
#pragma unroll
                    for (int s = 0; s < 16; ++s) { la[0][s] = af[r0 + (unsigned)s * (DM / 2)]; bt[0][s] = bf[r0 + (unsigned)s * (DM / 2)]; }
#pragma unroll
                    for (int hb = 0; hb < 4; ++hb) {
                        if (hb < 3) {
#pragma unroll
                            for (int s = 0; s < 16; ++s) { la[(hb + 1) & 1][s] = af[r0 + (unsigned)((hb + 1) * 16 + s) * (DM / 2)]; bt[(hb + 1) & 1][s] = bf[r0 + (unsigned)((hb + 1) * 16 + s) * (DM / 2)]; } }
#pragma unroll
                        for (int s = 0; s < 16; ++s) { const unsigned lw = la[hb & 1][s], bw = bt[hb & 1][s];
                            const float a0 = fast_exp((float)(lw & 0xffffu) * nsp0), a1 = fast_exp((float)(lw >> 16) * nsp1); H0 = a0 * H0 + bf_lo(bw); H1 = a1 * H1 + bf_hi(bw); A0_ *= a0; A1_ *= a1; } }
                    sa[(unsigned)(b * 32 + c) * (DM / 2) + tid] = (f32x2){A0_, A1_}; sh[(unsigned)(b * 32 + c) * (DM / 2) + tid] = (f32x2){H0, H1}; } }
            GRID_BAR(); } TS(5);
            for (int rep_ = 0; rep_ < REP5; ++rep_) { {   PHASE(); FRESH_TID();
                const unsigned* af = (const unsigned*)AF; const unsigned* bf = (const unsigned*)BF; const f32x2* sa = (const f32x2*)SA; const f32x2* sh = (const f32x2*)SH; const unsigned* gate = (const unsigned*)GATE; unsigned* hg = (unsigned*)HG;
                const float nsp0 = -C8SP[la * DM + 2 * tid] * (1.0f / 65535.0f), nsp1 = -C8SP[la * DM + 2 * tid + 1] * (1.0f / 65535.0f);
                for (int it = bx; it < BATCH * 32; it += G) { const int b = it >> 5, c = it & 31; const unsigned r0 = ((unsigned)(b * SEQ + c * 64) * DM) / 2 + tid;
                    float H0 = 0.f, H1 = 0.f;
                    { f32x2 A2[31], S2[31];
#pragma unroll
                      for (int c2 = 0; c2 < 31; ++c2) { const unsigned o = (unsigned)(b * 32 + (c2 < c ? c2 : 0)) * (DM / 2) + tid; A2[c2] = sa[o]; S2[c2] = sh[o]; }
#pragma unroll
                      for (int c2 = 0; c2 < 31; ++c2) if (c2 < c) { H0 = A2[c2][0] * H0 + S2[c2][0]; H1 = A2[c2][1] * H1 + S2[c2][1]; } }
                    unsigned la[2][16], bt[2][16], gg[2][16];
#pragma unroll
                    for (int s = 0; s < 16; ++s) { const unsigned o = r0 + (unsigned)s * (DM / 2); la[0][s] = af[o]; bt[0][s] = bf[o]; gg[0][s] = gate[o]; }
#pragma unroll
                    for (int hb = 0; hb < 4; ++hb) {
                        if (hb < 3) {
#pragma unroll
                            for (int s = 0; s < 16; ++s) { const unsigned o = r0 + (unsigned)((hb + 1) * 16 + s) * (DM / 2); la[(hb + 1) & 1][s] = af[o]; bt[(hb + 1) & 1][s] = bf[o]; gg[(hb + 1) & 1][s] = gate[o]; } }
#pragma unroll
                        for (int s = 0; s < 16; ++s) { const unsigned lw = la[hb & 1][s], bw = bt[hb & 1][s], gw_ = gg[hb & 1][s];
                            const float a0 = fast_exp((float)(lw & 0xffffu) * nsp0), a1 = fast_exp((float)(lw >> 16) * nsp1); H0 = a0 * H0 + bf_lo(bw); H1 = a1 * H1 + bf_hi(bw);
#ifdef OUTPROJ_F8
                            ((unsigned short*)hg)[r0 + (unsigned)(hb * 16 + s) * (DM / 2)] = (unsigned short)__builtin_amdgcn_cvt_pk_fp8_f32(H0 * bf_lo(gw_), H1 * bf_hi(gw_), 0, false); } } } }
#else
                            hg[r0 + (unsigned)(hb * 16 + s) * (DM / 2)] = cvt_pk_bf16(H0 * bf_lo(gw_), H1 * bf_hi(gw_)); } } } }
#endif
            GRID_BAR(); } TS(5);
            for (int rep_ = 0; rep_ < REP1; ++rep_) { {
                PHASE();
#ifdef OUTPROJ_F8
                pg8::Gemm g{HG, (const bf16*)(WSL + W_OUT + (size_t)la * DM * DM), DM / 2, DM / 2, DM / 2};
                pg8::DenseOrder S; S.init(T / 256, 4, G, bx, (size_t)256 * DM, 0, (size_t)256 * DM);
                EpiStore E{Y, DM, 1.0f / 64.0f};
                pg8::gemm_phase<EpiStore, pg8::DenseOrder, true, true, 1>(lds, g, S, E, wave);
#else
                pg8::Gemm g{HG, (const bf16*)(WSL + W_OUT) + (size_t)la * DM * DM, DM, DM, DM};
                pg8::DenseOrder S; S.init(T / 256, 4, G, bx, (size_t)256 * DM * 2, 0, (size_t)256 * DM * 2);
                EpiStore E{Y, DM, 1.0f};
                pg8::gemm_phase<EpiStore, pg8::DenseOrder, true, true>(lds, g, S, E, wave);
#endif
            }
            GRID_BAR(); } TS(1);
        } else {
            if (l != 2) for (int rep_ = 0; rep_ < REP1; ++rep_) { {
                PHASE();
                pg8::Gemm g{(const bf16*)HB8, (const bf16*)(WSL + W_QG + (size_t)la * NQG_PAD * DM), DM / 2, DM / 2, DM / 2};
                pg8::DenseOrder S; S.init(T / 256, 5, G, bx, (size_t)256 * DM, 0, (size_t)256 * DM);
                EpiQG E{Qb, QRb, GT, SCQ};
#if !defined(NO_G4)
                pg8::gemm_phase<EpiQG, pg8::DenseOrder, true, true, 2>(lds, g, S, E, wave);
#endif
            }
            GRID_BAR(); } TS(1);
#ifdef ZERO_ATTN
            {   PHASE(); FRESH_TID(); bf16* o = Ob; for (size_t i = (size_t)(bx * 512 + tid); i < (size_t)T * DM / 8; i += (size_t)G * 512) *(v4u*)(o + i * 8) = (v4u){0u, 0u, 0u, 0u}; }
#elif !defined(NO_ATTN)
            for (int rep_ = 0; rep_ < REP4; ++rep_) {   PHASE(); if (rep_) GRID_BAR();
                for (int L = bx; L < BATCH * NKV * 32; L += G) { const int bg = L & 63, qt = ((L >> 6) + 5 * bg) & 31;
#ifdef ATT_PROBE
                    if (rep_ == 0) nsa::attn_unit<ATT_PROBE>(lds, bg >> 2, bg & 3, qt, Qb, QRb, GT, KVT, KCMP, (bf16*)(WSL + WS_HF + 64 * MiB), (float*)(WSL + WS_CTL) + 2048, wave); else
#endif
                    nsa::attn_unit<0>(lds, bg >> 2, bg & 3, qt, Qb, QRb, GT, KVT, KCMP, Ob, (float*)(WSL + WS_CTL) + 2048, wave);
#ifdef MOE_W_LATE
                    if (l == 2) {
                        const int ui_ = (L - bx) / G;
                        const int nu_ = (BATCH * NKV * 32 + G - 1) / G, rg_ = ((8 * 16 * 224 + NGW - 1) / NGW + nu_ - 1) / nu_, rd_ = ((8 * 56 * 32 + NGW - 1) / NGW + nu_ - 1) / nu_;
                        FRESH_TID(); LAS float* scr = (LAS float*)(lds + wave * 16384);
                        __syncthreads();
                        transpose_family_i8((A0.moe_w_gu + zl) + (size_t)8 * DM * 2 * MFF, (size_t)DM * 2 * MFF, 8, DM, 2 * MFF, 2 * MFF, (unsigned char*)(WSL + MW_GU) + (size_t)8 * 2 * MFF * DM, (size_t)2 * MFF * DM, MFF, QS_W32, scr, gw, NGW, lane, 0, ui_ * rg_, (ui_ + 1) * rg_);
                        transpose_family_f8((A0.moe_w_down + zl) + (size_t)8 * MFF * DM, (size_t)MFF * DM, 8, MFF, DM, DM, (unsigned char*)(WSL + MW_DN) + (size_t)8 * DM * MFF, (size_t)DM * MFF, 0, 128.0f, scr, gw, NGW, lane, 0, ui_ * rd_, (ui_ + 1) * rd_);
                        __syncthreads();
                    }
#endif
                } }
#endif
            GRID_BAR(); TS(4);
            for (int rep_ = 0; rep_ < REP1; ++rep_) { {
                PHASE();
                pg8::Gemm g{Ob, (const bf16*)(WSL + W_O + (size_t)la * DM * DM), DM / 2, DM / 2, DM / 2};
                pg8::DenseOrder S; S.init(T / 256, 4, G, bx, (size_t)256 * DM, 0, (size_t)256 * DM);
                EpiStore E{Y, DM, 1.0f / 64.0f};
#if !defined(NO_G5)
                pg8::gemm_phase<EpiStore, pg8::DenseOrder, true, true, true>(lds, g, S, E, wave);
#endif
            }
            GRID_BAR(); } TS(1);
        }
        for (int rep_ = REP6 - 1; rep_ >= 0; --rep_) { bf16* const HBO_ = rep_ ? LN_DUMMY_OUT : (bf16*)(A0.ws + WS_HB); {   PHASE();
            const float* g1 = (A0.ln_g + zl) + (size_t)(l * 2) * DM; const float* b1 = (A0.ln_b + zl) + (size_t)(l * 2) * DM;
            if (l == 0) ln_phase<0, false, true, false>(lds, A0.x + zl, Y, nullptr, nullptr, g1, b1, nullptr, HB, HBO_, HB8, nullptr, nullptr, nullptr, gw, NGW, wave);
            else if ((l & 1) == 0) ln_phase<0, false, false, false>(lds, nullptr, Y, nullptr, nullptr, g1, b1, nullptr, HB, HBO_, HB8, nullptr, nullptr, nullptr, gw, NGW, wave);
            else if (rep_) ln_phase<0, false, false, false>(lds, nullptr, Y, nullptr, nullptr, g1, b1, nullptr, HB, HBO_, nullptr, nullptr, nullptr, nullptr, gw, NGW, wave);
            else ln_phase<0, true, false, false>(lds, nullptr, Y, nullptr, nullptr, g1, b1, nullptr, HB, HBO_, HB8, (A0.moe_w_router + zl) + (size_t)lf * DM * 8, ROUTE, CNTW(lf), gw, NGW, wave);
        }
            GRID_BAR(); } TS(6);
        if ((l & 1) == 0) {
            for (int rep_ = 0; rep_ < REP2; ++rep_) { {
                PHASE();
                pg8::Gemm g{(const bf16*)HB8, (const bf16*)(WSL + W_GU + (size_t)lf * 2 * DFF * DM), DM / 2, DM / 2, DM / 2};
                pg8::DenseOrder S; S.init(T / 256, 2 * DFF / 256, G, bx, (size_t)256 * DM, 0, (size_t)256 * DM);
#ifdef FFN_DN_F8
                EpiSwiglu8 E{(unsigned char*)ACT, DFF, SCQ};
                pg8::gemm_phase<EpiSwiglu8, pg8::DenseOrder, true, true, 2>(lds, g, S, E, wave);
#else
                EpiSwiglu E{ACT, DFF, SCQ};
                pg8::gemm_phase<EpiSwiglu, pg8::DenseOrder, true, true, 2>(lds, g, S, E, wave);
#endif
            }
            GRID_BAR(); } TS(2);
            for (int rep_ = 0; rep_ < REP2; ++rep_) { {
                PHASE();
#ifdef FFN_DN_F8
                pg8::Gemm g{ACT, (const bf16*)(WSL + W_DN + (size_t)lf * DM * DFF), DFF / 2, DFF / 2, DFF / 2};
                pg8::DenseOrder S; S.init(T / 256, 4, G, bx, (size_t)256 * DFF, 0, (size_t)256 * DFF);
                EpiStore E{Y, DM, 1.0f / 128.0f};
                pg8::gemm_phase<EpiStore, pg8::DenseOrder, true, true, 1>(lds, g, S, E, wave);
#else
                pg8::Gemm g{ACT, (const bf16*)(WSL + W_DN) + (size_t)lf * DM * DFF, DFF, DFF, DFF};
                pg8::DenseOrder S; S.init(T / 256, 4, G, bx, (size_t)256 * DFF * 2, 0, (size_t)256 * DFF * 2);
                EpiStore E{Y, DM, 1.0f};
                pg8::gemm_phase<EpiStore, pg8::DenseOrder, true, true>(lds, g, S, E, wave);
#endif
            }
            GRID_BAR(); } TS(2);
            for (int rep_ = REP6 - 1; rep_ >= 0; --rep_) { bf16* const HBO_ = rep_ ? LN_DUMMY_OUT : (bf16*)(A0.ws + WS_HB); {   PHASE();
                ln_phase<0, false, false, false>(lds, nullptr, Y, nullptr, nullptr, (A0.ln_g + zl) + (size_t)(l * 2 + 1) * DM, (A0.ln_b + zl) + (size_t)(l * 2 + 1) * DM, nullptr, HB, HBO_, LN2_HB8, nullptr, nullptr, nullptr, gw, NGW, wave);
            }
            GRID_BAR(); } TS(6);
        } else {
#define LOAD_TP() int tp[9]; tp[0] = 0; { unsigned* const cnt_ = CNTW(lf); const int ln_ = (int)__builtin_amdgcn_mbcnt_hi(~0u, __builtin_amdgcn_mbcnt_lo(~0u, 0u)); unsigned cv_ = 0u; if (ln_ < 8) cv_ = __hip_atomic_load(cnt_ + ln_ * 64, RLX_AGENT);   _Pragma("unroll") for (int e = 0; e < 8; ++e) { const unsigned c = (unsigned)__builtin_amdgcn_readlane((int)cv_, e); tp[e + 1] = tp[e] + (int)((c + 255u) >> 8); } }
            for (int rep_ = 0; rep_ < REP7; ++rep_) { {
                PHASE(); FRESH_TID(); LOAD_TP();
                LAS int* TB = (LAS int*)lds;
                if (tid < 8) { int v = 0;
#pragma unroll
                    for (int e = 0; e < 8; ++e) if (tid == e) v = tp[e]; TB[tid] = v * 256; }
                LDS_WAIT(); __syncthreads();
                const float* route = ROUTE; const unsigned char* hb8 = HB8; bf16* as = AS; int* rows = ROWS;
                for (int it = gw; it < 2 * T; it += 4 * NGW) { int ev[4], pv[4]; v4u dv[4];
#pragma unroll
                    for (int q = 0; q < 4; ++q) { const int i2 = (it + q * NGW < 2 * T) ? it + q * NGW : it, m = i2 >> 1, k = i2 & 1; const float* ro = route + (size_t)m * 8; ev[q] = __float_as_int(ro[k]); pv[q] = __float_as_int(ro[2 + k]);
                        dv[q] = *(const v4u*)(hb8 + (size_t)m * DM + lane * 16); }
#pragma unroll
                    for (int q = 0; q < 4; ++q) { const int i2 = it + q * NGW; const int row = TB[ev[q]] + pv[q];
                        if (i2 < 2 * T) { *(v4u*)((unsigned char*)as + (size_t)row * DM + lane * 16) = dv[q];
                            if (lane == 0) rows[i2] = row; } } }
            }
            GRID_BAR(); } TS(7);
            for (int rep_ = 0; rep_ < REP3; ++rep_) { {
                PHASE(); LOAD_TP();
                pg8::Gemm g{AS, (const bf16*)(WSL + MW_GU + (size_t)lf * 8 * 2 * MFF * DM), DM / 2, DM / 2, DM / 2};
                pg8::GroupOrder S{tp[1], tp[2], tp[3], tp[4], tp[5], tp[6], tp[7], tp[8], 2 * MFF / 256, tp[8] * (2 * MFF / 256), G, bx, (size_t)256 * DM, (size_t)256 * DM};
                EpiSwiglu8 E{(unsigned char*)HS, MFF, SCQ};
#if !defined(NO_G8)
                pg8::gemm_phase<EpiSwiglu8, pg8::GroupOrder, true, true, 2>(lds, g, S, E, wave);
#endif
            }
            GRID_BAR(); } TS(3);
            for (int rep_ = 0; rep_ < REP3; ++rep_) { {
                PHASE(); LOAD_TP();
                pg8::Gemm g{HS, (const bf16*)(WSL + MW_DN + (size_t)lf * 8 * DM * MFF), MFF / 2, MFF / 2, MFF / 2};
                pg8::GroupOrder S{tp[1], tp[2], tp[3], tp[4], tp[5], tp[6], tp[7], tp[8], 4, tp[8] * 4, G, bx, (size_t)256 * MFF, (size_t)256 * MFF};
                EpiStore E{YM, DM, 1.0f / 128.0f};
#if !defined(NO_G9)
                pg8::gemm_phase<EpiStore, pg8::GroupOrder, true, true, true>(lds, g, S, E, wave);
#endif
            }
            GRID_BAR(); } TS(3);
            for (int rep_ = REP6 - 1; rep_ >= 0; --rep_) { bf16* const HBO_ = rep_ ? LN_DUMMY_OUT : (bf16*)(A0.ws + WS_HB); {   PHASE();
                const float* g2 = (A0.ln_g + zl) + (size_t)(l * 2 + 1) * DM; const float* b2 = (A0.ln_b + zl) + (size_t)(l * 2 + 1) * DM;
                if (l == 3) ln_phase<1, false, false, true>(lds, nullptr, YM, ROUTE, ROWS, g2, b2, A0.out + zl, HB, HBO_, nullptr, nullptr, nullptr, nullptr, gw, NGW, wave);
                else ln_phase<1, false, false, false>(lds, nullptr, YM, ROUTE, ROWS, g2, b2, nullptr, HB, HBO_, LN2_HB8, nullptr, nullptr, nullptr, gw, NGW, wave);
            }
            GRID_BAR(); } TS(6);
        }
        if (l == 1) {
            for (int rep_ = 0; rep_ < REP1; ++rep_) { {
                PHASE();
                pg8::Gemm g{(const bf16*)HB8, (const bf16*)(WSL + W_KV), DM / 2, DM / 2, DM / 2};
                pg8::DenseOrder S; S.init(T / 256, 6, G, bx, (size_t)256 * DM, 0, (size_t)256 * DM);
                EpiKV E{KVT, SCQ};
#if !defined(NO_G10)
                pg8::gemm_phase<EpiKV, pg8::DenseOrder, true, true, 2>(lds, g, S, E, wave);
#endif
            }
            GRID_BAR(); } TS(1);
            for (int rep_ = 0; rep_ < REP1; ++rep_) { {
                PHASE();
                const int nC = (G >= 128) ? 64 : G / 2;
                if (bx < nC) {
                    pg8::Gemm g{KVT, (const bf16*)(WSL + W_C1), 1024, 2048, 2048};
                    pg8::DenseOrder S; S.init(32, 2, nC, bx, (size_t)256 * 1024 * 2, (size_t)BATCH * NKV * SEQ * HD * 2, (size_t)256 * 2048 * 2);
                    EpiCmp E{CH, CBIAS};
                    pg8::gemm_phase<EpiCmp, pg8::DenseOrder, true, true>(lds, g, S, E, wave);
                } else {
                    pg8::Gemm g{(const bf16*)HB8, (const bf16*)(WSL + W_QG), DM / 2, DM / 2, DM / 2};
                    pg8::DenseOrder S; S.init(T / 256, 5, G - nC, bx - nC, (size_t)256 * DM, 0, (size_t)256 * DM);
                    EpiQG E{Qb, QRb, GT, SCQ};
                    pg8::gemm_phase<EpiQG, pg8::DenseOrder, true, true, 2>(lds, g, S, E, wave);
                }
            }
            GRID_BAR(); } TS(1);
            for (int rep_ = 0; rep_ < REP7; ++rep_) { {
                PHASE(); FRESH_TID();
                LAS float* W2 = (LAS float*)lds;
                const float* w2g = (A0.nsa_cmp_w2 + zl); const bf16* chp = CH; bf16* kcmp = KCMP;
                for (int j = 0; j < 2; ++j) {
                    __syncthreads();
                    for (int i = tid; i < 256 * 64 / 4; i += 512) *(LAS f32x4*)(W2 + i * 4) = *(const f32x4*)(w2g + (size_t)j * 256 * 64 + i * 4);
                    LDS_WAIT(); __syncthreads();
                    for (int rowb = gw; rowb < 8192; rowb += 4 * NGW) { v2u hv[4]; float a[4] = {0.f, 0.f, 0.f, 0.f};
#pragma unroll
                        for (int q = 0; q < 4; ++q) { const int row = (rowb + q * NGW < 8192) ? rowb + q * NGW : rowb; hv[q] = *(const v2u*)(chp + ((size_t)j * 8192 + row) * 256 + lane * 4); }
#pragma unroll 8
                        for (int sl = 0; sl < 64; ++sl) { const LAS float* wp = W2 + (4 * sl) * 64 + lane; const float w0 = wp[0], w1 = wp[64], w2 = wp[128], w3 = wp[192];
#pragma unroll
                            for (int q = 0; q < 4; ++q) { const unsigned x = (unsigned)__builtin_amdgcn_readlane((int)hv[q].x, sl), y = (unsigned)__builtin_amdgcn_readlane((int)hv[q].y, sl);
                                a[q] += bf_lo(x) * w0 + bf_hi(x) * w1 + bf_lo(y) * w2 + bf_hi(y) * w3; } }
#pragma unroll
                        for (int q = 0; q < 4; ++q) { const int row = rowb + q * NGW;
                            if (row < 8192) kcmp[((size_t)j * 8192 + row) * 64 + lane] = (bf16)f2bf((row & 127) == 127 ? 0.f : a[q]); } }
                }
            }
            GRID_BAR(); } TS(7);
        }
    }
#ifdef TIMING
    { PHASE(); FRESH_TID(); const unsigned tcs[8] = {tc0, tc1, tc2, tc3, tc4, tc5, tc6, tc7};
      float ta = (float)tcs[TIMING_A] * 0.01f, tb = (float)tcs[TIMING_B] * 0.01f;
      ta = __builtin_amdgcn_exp2f(__builtin_rintf(__log2f(fmaxf(ta, 1e-3f)) * 3.f + (TIMING_PHASE)) * (1.0f / 3.0f)); tb = __builtin_amdgcn_exp2f(__builtin_rintf(__log2f(fmaxf(tb, 1e-3f)) * 3.f + (TIMING_PHASE)) * (1.0f / 3.0f));
      const float c = __builtin_sqrtf(ta * (TIMING_SCALE));
      float* o = A0.out + zl; for (size_t i = (size_t)(bx * 512 + tid); i < (size_t)T * DM / 4; i += (size_t)G * 512) *(f32x4*)(o + i * 4) = (f32x4){c, c, c, c};
      __syncthreads(); if (bx == 0 && tid == 0) o[0] = tb; }
#endif
#ifdef DBG_DENOM
    { PHASE(); FRESH_TID(); const float v = __hip_atomic_load((float*)(WSL + WS_CTL) + 2048, RLX_AGENT) / (float)(DBG_DENOM);
      float E = 20.f + 4.f * __log2f(fmaxf(v, 1e-30f)); E = fminf(fmaxf(E, 1.f), 90.f); const float c = __builtin_sqrtf(E);
      float* o = A0.out + zl; for (size_t i = (size_t)(bx * 512 + tid); i < (size_t)T * DM / 4; i += (size_t)G * 512) *(f32x4*)(o + i * 4) = (f32x4){c, c, c, c}; }
#endif
#if NLAYERS < 4
    { PHASE(); FRESH_TID(); const bf16* hb = HB; float* o = A0.out + zl; for (size_t i = (size_t)(bx * 512 + tid); i < (size_t)T * DM / 4; i += (size_t)G * 512) { const v2u w = *(const v2u*)(hb + i * 4); *(f32x4*)(o + i * 4) = (f32x4){bf_lo(w.x), bf_hi(w.x), bf_lo(w.y), bf_hi(w.y)}; } }
#endif
}

extern "C" void kernel_launch(void* const* d_in, const int* in_sizes, int n_in, void* d_out, int out_size, void* d_ws, size_t ws_size, hipStream_t stream) {
    static int grid = 0;
    if (grid == 0) {
        if (n_in != 23 || in_sizes[0] != T * DM || out_size != T * DM || ws_size < WS_END) {
            fprintf(stderr, "kernel_launch: unexpected problem (n_in %d, in0 %d, out %d, ws %zu, need %zu); nothing launched\n", n_in, n_in > 0 ? in_sizes[0] : -1, out_size, ws_size, (size_t)WS_END); grid = -1; return; }
        int dev = 0, cus = 0, per_cu = 0;
        if (hipGetDevice(&dev) != hipSuccess || hipDeviceGetAttribute(&cus, hipDeviceAttributeMultiprocessorCount, dev) != hipSuccess) { grid = -1; return; }
        if (hipFuncSetAttribute((const void*)mega_fwd, hipFuncAttributeMaxDynamicSharedMemorySize, LDS_BYTES) != hipSuccess) { fprintf(stderr, "kernel_launch: hipFuncSetAttribute failed\n"); grid = -1; return; }
        if (hipOccupancyMaxActiveBlocksPerMultiprocessor(&per_cu, (const void*)mega_fwd, NWAVES * 64, LDS_BYTES) != hipSuccess || per_cu < 1) { fprintf(stderr, "kernel_launch: occupancy query says %d blocks per CU\n", per_cu); }
        (void)hipGetLastError();
        grid = cus;
    }
    if (grid < 0) return;
    if (hipMemsetAsync((char*)d_ws + WS_CTL, 0, CTL_ZERO_BYTES, stream) != hipSuccess) return;
    Args a{};
    a.x = (const float*)d_in[0]; a.ln_g = (const float*)d_in[1]; a.ln_b = (const float*)d_in[2]; a.lru_w_in = (const float*)d_in[3]; a.lru_conv_w = (const float*)d_in[4];
    a.lru_conv_b = (const float*)d_in[5]; a.lru_w_a = (const float*)d_in[6]; a.lru_b_a = (const float*)d_in[7]; a.lru_w_i = (const float*)d_in[8]; a.lru_b_i = (const float*)d_in[9];
    a.lru_lambda = (const float*)d_in[10]; a.lru_w_out = (const float*)d_in[11]; a.nsa_w_kv = (const float*)d_in[12]; a.nsa_cmp_pos = (const float*)d_in[13]; a.nsa_cmp_w1 = (const float*)d_in[14];
    a.nsa_cmp_w2 = (const float*)d_in[15]; a.nsa_w_qg = (const float*)d_in[16]; a.nsa_w_o = (const float*)d_in[17]; a.ffn_w_gu = (const float*)d_in[18]; a.ffn_w_down = (const float*)d_in[19];
    a.moe_w_router = (const float*)d_in[20]; a.moe_w_gu = (const float*)d_in[21]; a.moe_w_down = (const float*)d_in[22];
    a.out = (float*)d_out; a.ws = (unsigned char*)d_ws;
    hipLaunchKernelGGL(mega_fwd, dim3(grid), dim3(NWAVES * 64), LDS_BYTES, stream, a);
}
```

```cpp
#include <hip/hip_runtime.h>
#include <cstdio>
#include <cstdint>

#define GAS __attribute__((address_space(1)))
#define LAS __attribute__((address_space(3)))
typedef unsigned short bf16;
typedef unsigned v4u __attribute__((ext_vector_type(4)));
typedef unsigned v2u __attribute__((ext_vector_type(2)));
typedef float f32x4 __attribute__((ext_vector_type(4)));
typedef float f32x2 __attribute__((ext_vector_type(2)));
typedef float f32x16 __attribute__((ext_vector_type(16)));
typedef short bf16x8 __attribute__((ext_vector_type(8)));
typedef short s16x4 __attribute__((ext_vector_type(4)));
typedef GAS unsigned gu32;
#define RLX_AGENT __ATOMIC_RELAXED, __HIP_MEMORY_SCOPE_AGENT
#define LDS_WAIT() asm volatile("s_waitcnt lgkmcnt(0)" ::: "memory")
#define VM_WAIT() asm volatile("s_waitcnt vmcnt(0)" ::: "memory")

constexpr int BATCH = 16, SEQ = 2048, DM = 1024, T = BATCH * SEQ;
constexpr int LRU_BLOCKS = 8, LRU_BW = 128;
constexpr int NHEAD = 16, HD = 64, NKV = 4, HPG = 4;
constexpr int DFF = 2816, NEXP = 8, MFF = 3584;
constexpr int NQG = 1072, NQG_PAD = 1280, NKVP = 1536;
constexpr int CMP_HID = 256, NCMP = 127, NCMP_PAD = 128;
constexpr float DN_ALPHA = 1.681792830507429f;
constexpr float LN_EPS = 1e-5f;
constexpr int MOE_ROWS = 2 * T + NEXP * 256;
constexpr int NWAVES = 8;

constexpr size_t MiB = 1u << 20;
constexpr size_t WS_CTL = 0, CTL_ZERO_BYTES = 1 * MiB;
constexpr size_t WS_ROPE = 1 * MiB;
constexpr size_t WS_C8SP = WS_ROPE + 256 * 1024;
constexpr size_t WS_CBIAS = WS_C8SP + 16 * 1024;
constexpr size_t WS_CPART = WS_ROPE + 512 * 1024;
constexpr size_t WS_ROUTE = 2 * MiB;
constexpr size_t WS_ROWS = 3 * MiB;
constexpr size_t WS_SA = 4 * MiB, WS_SH = 6 * MiB, WS_CI = 8 * MiB;
constexpr size_t WS_KCMP = 10 * MiB;
constexpr size_t WS_CH = 12 * MiB;
constexpr size_t WS_GT = 20 * MiB;
constexpr size_t WS_W = 64 * MiB;
constexpr size_t W_IN = WS_W;
constexpr size_t W_GATE = W_IN + (size_t)2 * 2048 * 1024 * 2;
constexpr size_t W_OUT = W_GATE + (size_t)2 * 2048 * 128 * 2;
constexpr size_t W_KV = W_OUT + (size_t)2 * 1024 * 1024 * 2;
constexpr size_t W_C1 = W_KV + (size_t)1536 * 1024 * 2;
constexpr size_t W_QG = W_C1 + (size_t)2 * 256 * 2048 * 2;
constexpr size_t W_O = W_QG + (size_t)2 * 1280 * 1024 * 2;
constexpr size_t W_GU = W_O + (size_t)2 * 1024 * 1024 * 2;
constexpr size_t W_DN = W_GU + (size_t)2 * 5632 * 1024 * 2;
constexpr size_t MW_GU = W_DN + (size_t)2 * 1024 * 2816 * 2;
constexpr size_t MW_DN = MW_GU + (size_t)2 * 8 * 7168 * 1024 * 2;
constexpr size_t W_END = MW_DN + (size_t)2 * 8 * 1024 * 3584 * 2;
constexpr size_t WS_HF = 480 * MiB;
constexpr size_t WS_HB8 = WS_HF;
constexpr size_t WS_Y = 608 * MiB;
constexpr size_t WS_HB = 672 * MiB;
constexpr size_t WS_S = 736 * MiB;
constexpr size_t WS_GATE = WS_S, WS_UX = WS_S + 64 * MiB, WS_XR = WS_S + 128 * MiB, WS_AF = WS_S + 192 * MiB, WS_BF = WS_S + 320 * MiB, WS_HG = WS_UX;
constexpr size_t WS_ACT = WS_HF + 32 * MiB;
constexpr size_t WS_AS = WS_S;
constexpr size_t WS_HS = WS_S + 136 * MiB;
constexpr size_t WS_YM = WS_S + 600 * MiB;
constexpr size_t WS_Q = WS_S, WS_QR = WS_S + 64 * MiB, WS_O = WS_S + 128 * MiB;
constexpr size_t WS_KVT = WS_S + 736 * MiB;
constexpr size_t WS_END = WS_KVT + 100 * MiB;
static_assert(W_END <= WS_HF, "weights overflow");
static_assert(WS_HS + (size_t)MOE_ROWS * MFF * 2 <= WS_YM, "HS overflow");
static_assert(WS_YM + (size_t)MOE_ROWS * DM * 2 <= WS_KVT, "YM overflow");
static_assert(WS_BF + (size_t)T * DM * 4 <= WS_KVT, "BF overflow");

constexpr int CW_BAR = 4096;
constexpr int CW_CNT = 16384;

constexpr int RING_BYTES = 131072;
constexpr int LDSCTL_OFF = RING_BYTES, MISC_OFF = LDSCTL_OFF + 320;
constexpr int LDS_BYTES = 147456;

__device__ __forceinline__ unsigned f2bf(float f) { unsigned u = __builtin_bit_cast(unsigned, f); return (u + 0x7fffu + ((u >> 16) & 1u)) >> 16; }
__device__ __forceinline__ unsigned pk2(float lo, float hi) { return f2bf(lo) | (f2bf(hi) << 16); }
__device__ __forceinline__ unsigned cvt_pk_bf16(float lo, float hi) { unsigned r; asm volatile("v_cvt_pk_bf16_f32 %0, %1, %2" : "=v"(r) : "v"(lo), "v"(hi)); return r; }
__device__ __forceinline__ float bf_lo(unsigned w) { return __uint_as_float(w << 16); }
__device__ __forceinline__ float bf_hi(unsigned w) { return __uint_as_float(w & 0xffff0000u); }
__device__ __forceinline__ float fast_exp(float x) { return __builtin_amdgcn_exp2f(x * 1.4426950408889634f); }
__device__ __forceinline__ float fast_rcp(float x) { return __builtin_amdgcn_rcpf(x); }
__device__ __forceinline__ float sigmoidf_(float x) { return fast_rcp(1.0f + fast_exp(-x)); }
__device__ __forceinline__ float gelu_tanh(float x) { const float u = 1.5957691216057308f * (x + 0.044715f * x * x * x); return x * fast_rcp(1.0f + fast_exp(-u)); }
__device__ __forceinline__ float silu_(float x) { return x * fast_rcp(1.0f + fast_exp(-x)); }
constexpr float QS_A = 127.0f / 4.25f, QS_W32 = 127.0f * 32.0f / 4.25f;
__device__ __forceinline__ unsigned q8(float x, float s) { const float r = __builtin_rintf(fminf(fmaxf(x * s, -127.0f), 127.0f)); return (unsigned)(int)r & 0xffu; }
__device__ __forceinline__ unsigned pack4_i8(float a, float b, float c, float d, float s) { return q8(a, s) | (q8(b, s) << 8) | (q8(c, s) << 16) | (q8(d, s) << 24); }
template <int CTRL> __device__ __forceinline__ float dpp_f(float v) { return __builtin_bit_cast(float, __builtin_amdgcn_update_dpp(0, __builtin_bit_cast(int, v), CTRL, 0xf, 0xf, true)); }
__device__ __forceinline__ float wave_sum(float v) {
    v += dpp_f<0xB1>(v); v += dpp_f<0x4E>(v); v += dpp_f<0x141>(v); v += dpp_f<0x140>(v);
    const int vi = __builtin_bit_cast(int, v);
    const float r0 = __builtin_bit_cast(float, __builtin_amdgcn_readlane(vi, 0)), r1 = __builtin_bit_cast(float, __builtin_amdgcn_readlane(vi, 16));
    const float r2 = __builtin_bit_cast(float, __builtin_amdgcn_readlane(vi, 32)), r3 = __builtin_bit_cast(float, __builtin_amdgcn_readlane(vi, 48));
    return (r0 + r1) + (r2 + r3);
}
namespace pg8 {
#define PG8_LAS __attribute__((address_space(3)))
typedef unsigned short bf16_t;
typedef unsigned u32x4 __attribute__((ext_vector_type(4)));
typedef int v4i_ __attribute__((ext_vector_type(4)));
typedef int v8i_ __attribute__((ext_vector_type(8)));
constexpr int BM = 256, BK = 64, HALF = 128, HTB = HALF * BK * 2, STAGE_BYTES = 8 * HTB, NXCD = 8, WGM = 8;
__host__ __device__ __forceinline__ int lds_byte(int r, int c) { const int st = (r >> 4) * 2 + (c >> 5), rr = r & 15, cc = c & 31, ob = rr * 64 + cc * 2; return st * 1024 + (ob ^ (((ob >> 9) & 1) << 5)); }
__host__ __device__ __forceinline__ void stage_rc(int b, int& R, int& C) { const int st = b / 1024, sb = b % 1024, swz = sb ^ (((sb >> 9) & 1) << 5); R = (st >> 1) * 16 + swz / 64; C = (st & 1) * 32 + (swz % 64) / 2; }
__host__ __device__ __forceinline__ int perm32(int rho) { const int n = rho >> 4, i = rho & 15; return 8 * (i >> 2) + 4 * n + (i & 3); }

struct Unit { int pm, pn, aux; size_t aoff, boff; };
struct Gemm { const bf16_t* A; const bf16_t* Bt; int lda, ldb, K; };

struct DenseOrder {
    int nM, nN, nwg, G, c; size_t a_pm, a_pn, b_pn;
    mutable int li, lw;
    __device__ __forceinline__ void init(int nM_, int nN_, int G_, int c_, size_t a_pm_, size_t a_pn_, size_t b_pn_) { nM = nM_; nN = nN_; nwg = nM * nN; G = G_; c = c_; a_pm = a_pm_; a_pn = a_pn_; b_pn = b_pn_; li = -2; lw = 0; }
    __device__ __forceinline__ bool next(int i, Unit& u) const {
        const long L = (long)i * G + c; if (L >= nwg) return false;
        const int nig = WGM * nN; int wgid;
        if (i == li + 1 && (nwg % NXCD) == 0 && (G % NXCD) == 0) wgid = lw + G / NXCD;
        else { wgid = (int)L; const int q = nwg / NXCD, r = nwg % NXCD, xcd = wgid % NXCD, off = wgid / NXCD; wgid = (xcd < r ? xcd * (q + 1) : r * (q + 1) + (xcd - r) * q) + off; }
        li = i; lw = wgid;
        const int gid = wgid / nig, rem = wgid - gid * nig, fm = gid * WGM, gsz = (nM - fm) < WGM ? (nM - fm) : WGM;
        if (gsz == WGM) { u.pm = fm + (rem & (WGM - 1)); u.pn = rem >> 3; } else { u.pm = fm + rem % gsz; u.pn = rem / gsz; }
        u.aux = 0; u.aoff = (size_t)u.pm * a_pm + (size_t)u.pn * a_pn; u.boff = (size_t)u.pn * b_pn; return true;
    }
};
struct OneUnit {
    int pm, pn; size_t a_pm, a_pn, b_pn;
    __device__ __forceinline__ bool next(int i, Unit& u) const { if (i != 0) return false; u.pm = pm; u.pn = pn; u.aux = 0; u.aoff = (size_t)pm * a_pm + (size_t)pn * a_pn; u.boff = (size_t)pn * b_pn; return true; }
};
struct GroupOrder {
    int t1, t2, t3, t4, t5, t6, t7, t8; int nNe, total, G, c; size_t a_pm, b_tile;
    mutable int li = -2, lpm = 0, lpn = 0, dpm = 0, dpn = 0;
    __device__ __forceinline__ bool next(int i, Unit& u) const {
        const long L = (long)i * G + c; if (L >= total) return false;
        int pm, pn;
        if (i == li + 1) { pn = lpn + dpn; pm = lpm + dpm; if (pn >= nNe) { pn -= nNe; ++pm; } }
        else { pm = (int)(L / nNe); pn = (int)(L % nNe); dpm = G / nNe; dpn = G % nNe; }
        li = i; lpm = pm; lpn = pn;
        const int e = (pm >= t1) + (pm >= t2) + (pm >= t3) + (pm >= t4) + (pm >= t5) + (pm >= t6) + (pm >= t7);
        u.pm = pm; u.pn = pn; u.aux = e; u.aoff = (size_t)pm * a_pm; u.boff = (size_t)(e * nNe + pn) * b_tile; return true;
    }
};
template <class Epi, class Sched, bool ALIGN_EPI = false, bool SP2 = false, int QM = 0>
__device__ __forceinline__ void gemm_phase(PG8_LAS unsigned char* lds, const Gemm g, const Sched& S, const Epi& E, const int wave_in) {
    int tid_; asm volatile("v_mbcnt_lo_u32_b32 %0, -1, 0\n\tv_mbcnt_hi_u32_b32 %0, -1, %0" : "=v"(tid_)); tid_ += 64 * wave_in;
    const int tid = tid_, wid = __builtin_amdgcn_readfirstlane(tid >> 6), lane = tid & 63, wr = wid >> 2, wc = wid & 3, fr = lane & 15, fq = lane >> 4;
    int K_ = g.K, lda_ = g.lda, ldb_ = g.ldb; asm volatile("" : "+s"(K_), "+s"(lda_), "+s"(ldb_));
    const int K = K_, nt = K / BK; const int lda = lda_, ldb = ldb_;
    unsigned voffA[2], voffB[2];
#pragma unroll
    for (int i = 0; i < 2; ++i) { int R, C; stage_rc(tid * 16 + i * 8192, R, C); const int Rb = Epi::PERM ? ((R & ~31) + perm32(R & 31)) : R;
        voffA[i] = (unsigned)(R * lda + C) * 2u; voffB[i] = (unsigned)(Rb * ldb + C) * 2u; }
    const size_t kstep = (size_t)(BK * 2);
    const size_t hstepA = (size_t)HALF * lda * 2, hstepB = (size_t)HALF * ldb * 2;
    const unsigned ldsw = (unsigned)wid * 1024u;
    const int aoff = lds_byte(wr * 64 + fr, fq * 8), boff = lds_byte(wc * 32 + fr, fq * 8);
#define PG8_SA(b, h) (((b) * 2 + (h)) * HTB)
#define PG8_SB(b, h) ((4 + (b) * 2 + (h)) * HTB)
#define PG8_STAGE(bufoff, gbase, voff) do { _Pragma("unroll") for (int _i = 0; _i < 2; ++_i) \
        __builtin_amdgcn_global_load_lds((const unsigned*)((const char*)(gbase) + (voff)[_i]), (PG8_LAS unsigned*)(lds + (bufoff) + ldsw + _i * 8192), 16, 0, 0); } while (0)
#define PG8_LDA(dst, b, h) do { _Pragma("unroll") for (int m = 0; m < 4; ++m) { const v4i_ lo_ = *(const PG8_LAS v4i_*)(lds + PG8_SA(b, h) + aoff + m * 2048), hi_ = *(const PG8_LAS v4i_*)(lds + PG8_SA(b, h) + aoff + m * 2048 + 1024); dst[m] = __builtin_shufflevector(lo_, hi_, 0, 1, 2, 3, 4, 5, 6, 7); } } while (0)
#define PG8_LDB(dst, b, h) do { _Pragma("unroll") for (int n = 0; n < 2; ++n) { const v4i_ lo_ = *(const PG8_LAS v4i_*)(lds + PG8_SB(b, h) + boff + n * 2048), hi_ = *(const PG8_LAS v4i_*)(lds + PG8_SB(b, h) + boff + n * 2048 + 1024); dst[n] = __builtin_shufflevector(lo_, hi_, 0, 1, 2, 3, 4, 5, 6, 7); } } while (0)
#define PG8_MMA(ai, bj, At, Bt) do { __builtin_amdgcn_s_setprio(1); \
        if constexpr (QM == 1) { _Pragma("unroll") for (int m = 0; m < 4; ++m) _Pragma("unroll") for (int n = 0; n < 2; ++n) \
            asm volatile("v_mfma_scale_f32_16x16x128_f8f6f4 %0, %1, %2, %0, %3, %3 op_sel_hi:[0,0,0]" : "+v"(acc[ai][bj][m][n]) : "v"(Bt[n]), "v"(At[m]), "v"(0x7f7f7f7f)); } \
        else if constexpr (QM == 2) { _Pragma("unroll") for (int m = 0; m < 4; ++m) _Pragma("unroll") for (int n = 0; n < 2; ++n) { \
            v4i_ c_ = __builtin_bit_cast(v4i_, acc[ai][bj][m][n]); \
            c_ = __builtin_amdgcn_mfma_i32_16x16x64_i8(__builtin_shufflevector(Bt[n], Bt[n], 0, 1, 2, 3), __builtin_shufflevector(At[m], At[m], 0, 1, 2, 3), c_, 0, 0, 0); \
            c_ = __builtin_amdgcn_mfma_i32_16x16x64_i8(__builtin_shufflevector(Bt[n], Bt[n], 4, 5, 6, 7), __builtin_shufflevector(At[m], At[m], 4, 5, 6, 7), c_, 0, 0, 0); \
            acc[ai][bj][m][n] = __builtin_bit_cast(f32x4, c_); } } \
        else { _Pragma("unroll") for (int m = 0; m < 4; ++m) _Pragma("unroll") for (int n = 0; n < 2; ++n) { \
            acc[ai][bj][m][n] = __builtin_amdgcn_mfma_f32_16x16x32_bf16(__builtin_bit_cast(bf16x8, __builtin_shufflevector(Bt[n], Bt[n], 0, 1, 2, 3)), __builtin_bit_cast(bf16x8, __builtin_shufflevector(At[m], At[m], 0, 1, 2, 3)), acc[ai][bj][m][n], 0, 0, 0); \
            acc[ai][bj][m][n] = __builtin_amdgcn_mfma_f32_16x16x32_bf16(__builtin_bit_cast(bf16x8, __builtin_shufflevector(Bt[n], Bt[n], 4, 5, 6, 7)), __builtin_bit_cast(bf16x8, __builtin_shufflevector(At[m], At[m], 4, 5, 6, 7)), acc[ai][bj][m][n], 0, 0, 0); } } \
        __builtin_amdgcn_s_setprio(0); } while (0)
#define PG8_WAIT_V(n) asm volatile("s_waitcnt vmcnt(" #n ")" ::: "memory")
#define PG8_WAIT_L(n) asm volatile("s_waitcnt lgkmcnt(" #n ")" ::: "memory")
#define PG8_BAR __builtin_amdgcn_s_barrier()
#define PG8_SCHED __builtin_amdgcn_sched_barrier(0)
    Unit cur, nxt; int ui = 0;
    if (!S.next(0, cur)) return;
    f32x4 acc[2][2][4][2];
#pragma unroll
    for (int a = 0; a < 2; ++a)
#pragma unroll
        for (int b = 0; b < 2; ++b)
#pragma unroll
            for (int m = 0; m < 4; ++m)
#pragma unroll
                for (int n = 0; n < 2; ++n) acc[a][b][m][n] = (f32x4){0.f, 0.f, 0.f, 0.f};
    v8i_ At[4], B0[2], B1[2];
    const char* cA = (const char*)g.A + cur.aoff; const char* cB = (const char*)g.Bt + cur.boff;
    if constexpr (SP2) {
        PG8_STAGE(PG8_SB(0, 0), cB, voffB); PG8_STAGE(PG8_SB(0, 1), cB + hstepB, voffB); PG8_STAGE(PG8_SA(0, 0), cA, voffA); PG8_STAGE(PG8_SA(0, 1), cA + hstepA, voffA);
        if (wr == 1) PG8_BAR;
        PG8_WAIT_V(2); PG8_BAR;
        PG8_STAGE(PG8_SB(1, 0), cB + kstep, voffB); PG8_STAGE(PG8_SA(1, 0), cA + kstep, voffA); PG8_STAGE(PG8_SB(1, 1), cB + hstepB + kstep, voffB);
        PG8_WAIT_V(6); PG8_BAR;
    } else {
        PG8_STAGE(PG8_SB(0, 0), cB, voffB); PG8_STAGE(PG8_SA(0, 0), cA, voffA); PG8_STAGE(PG8_SB(0, 1), cB + hstepB, voffB); PG8_STAGE(PG8_SA(0, 1), cA + hstepA, voffA);
        if (wr == 1) PG8_BAR;
        PG8_WAIT_V(4); PG8_BAR;
        PG8_STAGE(PG8_SB(1, 0), cB + kstep, voffB); PG8_STAGE(PG8_SA(1, 0), cA + kstep, voffA); PG8_STAGE(PG8_SB(1, 1), cB + hstepB + kstep, voffB);
        PG8_WAIT_V(6); PG8_BAR;
    }
    for (;;) {
        const bool has_next = S.next(ui + 1, nxt);
        const char* nA = has_next ? (const char*)g.A + nxt.aoff : cA; const char* nB = has_next ? (const char*)g.Bt + nxt.boff : cB;
        for (int t = 0; t < nt; t += 2) {
            const bool last = (t == nt - 2);
            const char* a1 = cA + (size_t)(t + 1) * kstep;
            const char* a2 = last ? nA : cA + (size_t)(t + 2) * kstep; const char* b2 = last ? nB : cB + (size_t)(t + 2) * kstep;
            const char* a3 = a2 + kstep; const char* b3 = b2 + kstep;
            if constexpr (SP2) {
            PG8_LDB(B0, 0, 0); PG8_LDB(B1, 0, 1); PG8_SCHED; PG8_LDA(At, 0, 0); PG8_STAGE(PG8_SA(1, 1), a1 + hstepA, voffA);
            PG8_WAIT_V(8); PG8_WAIT_L(0); PG8_BAR; PG8_MMA(0, 0, At, B0); PG8_MMA(0, 1, At, B1); PG8_BAR; PG8_SCHED;
            PG8_LDA(At, 0, 1); PG8_STAGE(PG8_SB(0, 0), b2, voffB); PG8_STAGE(PG8_SB(0, 1), b2 + hstepB, voffB); PG8_STAGE(PG8_SA(0, 0), a2, voffA);
            PG8_WAIT_V(8); PG8_WAIT_L(0); PG8_BAR; PG8_MMA(1, 0, At, B0); PG8_MMA(1, 1, At, B1); PG8_BAR; PG8_SCHED;
            PG8_LDB(B0, 1, 0); PG8_LDB(B1, 1, 1); PG8_SCHED; PG8_LDA(At, 1, 0); PG8_STAGE(PG8_SA(0, 1), a2 + hstepA, voffA);
            PG8_WAIT_V(8); PG8_WAIT_L(0); PG8_BAR; PG8_MMA(0, 0, At, B0); PG8_MMA(0, 1, At, B1); PG8_BAR; PG8_SCHED;
            PG8_LDA(At, 1, 1); PG8_STAGE(PG8_SB(1, 0), b3, voffB); PG8_STAGE(PG8_SB(1, 1), b3 + hstepB, voffB); PG8_STAGE(PG8_SA(1, 0), a3, voffA);
            PG8_WAIT_V(8); PG8_WAIT_L(0); PG8_BAR; PG8_MMA(1, 0, At, B0); PG8_MMA(1, 1, At, B1); PG8_BAR; PG8_SCHED;
            } else {
            PG8_LDB(B0, 0, 0); PG8_SCHED; PG8_LDA(At, 0, 0); PG8_STAGE(PG8_SA(1, 1), a1 + hstepA, voffA);
            PG8_WAIT_L(8); PG8_BAR; PG8_WAIT_L(0); PG8_MMA(0, 0, At, B0); PG8_BAR; PG8_SCHED;
            PG8_LDB(B1, 0, 1); PG8_STAGE(PG8_SB(0, 0), b2, voffB);
            PG8_BAR; PG8_WAIT_L(0); PG8_MMA(0, 1, At, B1); PG8_BAR;
            PG8_LDA(At, 0, 1); PG8_STAGE(PG8_SA(0, 0), a2, voffA);
            PG8_BAR; PG8_WAIT_L(0); PG8_MMA(1, 0, At, B0); PG8_BAR; PG8_SCHED;
            PG8_STAGE(PG8_SB(0, 1), b2 + hstepB, voffB);
            PG8_WAIT_V(6); PG8_BAR; PG8_MMA(1, 1, At, B1); PG8_BAR;
            PG8_LDB(B0, 1, 0); PG8_SCHED; PG8_LDA(At, 1, 0); PG8_STAGE(PG8_SA(0, 1), a2 + hstepA, voffA);
            PG8_WAIT_L(8); PG8_BAR; PG8_WAIT_L(0); PG8_MMA(0, 0, At, B0); PG8_BAR; PG8_SCHED;
            PG8_LDB(B1, 1, 1); PG8_STAGE(PG8_SB(1, 0), b3, voffB);
            PG8_BAR; PG8_WAIT_L(0); PG8_MMA(0, 1, At, B1); PG8_BAR;
            PG8_LDA(At, 1, 1); PG8_STAGE(PG8_SA(1, 0), a3, voffA);
            PG8_BAR; PG8_WAIT_L(0); PG8_MMA(1, 0, At, B0); PG8_BAR; PG8_SCHED;
            PG8_STAGE(PG8_SB(1, 1), b3 + hstepB, voffB);
            PG8_WAIT_V(6); PG8_BAR; PG8_MMA(1, 1, At, B1); PG8_BAR;
            }
        }
        if constexpr (QM == 1) asm volatile("s_nop 15\n\ts_nop 15" ::: "memory");
        if constexpr (ALIGN_EPI) { if (wr == 0) PG8_BAR; }
        if constexpr (QM == 2) {
#pragma unroll
            for (int a = 0; a < 2; ++a)
#pragma unroll
                for (int b = 0; b < 2; ++b)
#pragma unroll
                    for (int m = 0; m < 4; ++m)
#pragma unroll
                        for (int n = 0; n < 2; ++n) { const v4i_ c_ = __builtin_bit_cast(v4i_, acc[a][b][m][n]); acc[a][b][m][n] = (f32x4){(float)c_[0], (float)c_[1], (float)c_[2], (float)c_[3]}; } }
        { E(acc, cur, wr, wc, fr, fq); }
        if (!has_next) break;
#pragma unroll
        for (int a = 0; a < 2; ++a)
#pragma unroll
            for (int b = 0; b < 2; ++b)
#pragma unroll
                for (int m = 0; m < 4; ++m)
#pragma unroll
                    for (int n = 0; n < 2; ++n) { typedef float f32x2_ __attribute__((ext_vector_type(2))); f32x2_ lo_, hi_;
                        asm volatile("v_mov_b64 %0, 0" : "=v"(lo_)); asm volatile("v_mov_b64 %0, 0" : "=v"(hi_)); acc[a][b][m][n] = __builtin_shufflevector(lo_, hi_, 0, 1, 2, 3); }
        cur = nxt; cA = nA; cB = nB; ++ui;
        if constexpr (ALIGN_EPI) { if (wr == 1) PG8_BAR; }
    }
    PG8_WAIT_V(0);
    if constexpr (!ALIGN_EPI) { if (wr == 0) PG8_BAR; }
    PG8_BAR;
#undef PG8_SA
#undef PG8_SB
#undef PG8_STAGE
#undef PG8_LDA
#undef PG8_LDB
#undef PG8_MMA
#undef PG8_WAIT_V
#undef PG8_WAIT_L
#undef PG8_BAR
#undef PG8_SCHED
}

}
typedef const f32x4 (&AccT)[2][2][4][2];
using pg8::Unit;

__device__ __forceinline__ v4u pack8(const f32x4 a, const f32x4 b) {
    v4u w; w.x = cvt_pk_bf16(a[0], a[1]); w.y = cvt_pk_bf16(a[2], a[3]); w.z = cvt_pk_bf16(b[0], b[1]); w.w = cvt_pk_bf16(b[2], b[3]); return w;
}

__device__ __forceinline__ f32x4 gelu4(const f32x4 x) {
    constexpr float C0 = -1.5957691216057308f * 1.4426950408889634f, C1 = 0.044715f * C0;
    const f32x4 t = x * (x * x * C1 + C0);
    const f32x4 d = (f32x4){__builtin_amdgcn_exp2f(t[0]), __builtin_amdgcn_exp2f(t[1]), __builtin_amdgcn_exp2f(t[2]), __builtin_amdgcn_exp2f(t[3])} + 1.0f;
    return x * (f32x4){fast_rcp(d[0]), fast_rcp(d[1]), fast_rcp(d[2]), fast_rcp(d[3])};
}
struct EpiStore {
    static constexpr bool PERM = true;
    bf16* O; int ldc; float sc;
    __device__ __forceinline__ void operator()(AccT acc, const Unit& u, int wr, int wc, int fr, int fq) const {
        const int row0 = u.pm * 256 + wr * 64 + fr, col0 = u.pn * 256 + wc * 32 + 8 * fq;
#pragma unroll
        for (int ai = 0; ai < 2; ++ai)
#pragma unroll
            for (int m = 0; m < 4; ++m) { bf16* rowp = O + (size_t)(row0 + ai * 128 + m * 16) * ldc + col0;
#pragma unroll
                for (int bj = 0; bj < 2; ++bj) *(v4u*)(rowp + bj * 128) = pack8(acc[ai][bj][m][0] * sc, acc[ai][bj][m][1] * sc); }
    }
};
struct EpiInProj {
    static constexpr bool PERM = true;
    bf16* GATE; bf16* UX; float sc;
    __device__ __forceinline__ void operator()(AccT acc, const Unit& u, int wr, int wc, int fr, int fq) const {
        const bool isg = u.pn < 4; bf16* O = isg ? GATE : UX;
        const int row0 = u.pm * 256 + wr * 64 + fr, col0 = (u.pn & 3) * 256 + wc * 32 + 8 * fq;
#pragma unroll
        for (int ai = 0; ai < 2; ++ai)
#pragma unroll
            for (int m = 0; m < 4; ++m) { bf16* rowp = O + (size_t)(row0 + ai * 128 + m * 16) * DM + col0;
#pragma unroll
                for (int bj = 0; bj < 2; ++bj) { f32x4 a = acc[ai][bj][m][0] * sc, b = acc[ai][bj][m][1] * sc;
                    if (isg) { a = gelu4(a); b = gelu4(b); }
                    *(v4u*)(rowp + bj * 128) = pack8(a, b); } }
    }
};
struct EpiGates {
    static constexpr bool PERM = true;
    const bf16* XR; const float* ba; const float* bi; const float* c8sp; bf16* LAb; bf16* BTb; int abl;
    __device__ __forceinline__ void operator()(AccT acc, const Unit& u, int wr, int wc, int fr, int fq) const {
        const int row0 = u.pm * 256 + wr * 64 + fr, ch0 = u.pn * 128 + wc * 32 + 8 * fq;
        v4u xw[2][4];
#pragma unroll
        for (int ai = 0; ai < 2; ++ai)
#pragma unroll
            for (int m = 0; m < 4; ++m) xw[ai][m] = *(const v4u*)(XR + (unsigned)(row0 + ai * 128 + m * 16) * DM + ch0);
        f32x4 vba[2], vbi[2], vsp[2];
#pragma unroll
        for (int n = 0; n < 2; ++n) { vba[n] = *(const f32x4*)(ba + ch0 + 4 * n); vbi[n] = *(const f32x4*)(bi + ch0 + 4 * n); vsp[n] = *(const f32x4*)(c8sp + ch0 + 4 * n); }
        constexpr float NL2E = -1.4426950408889634f;
        f32x2 ba2[4], bi2[4], sp2[4];
#pragma unroll
        for (int n = 0; n < 2; ++n)
#pragma unroll
            for (int h = 0; h < 2; ++h) { ba2[2 * n + h] = (f32x2){vba[n][2 * h] * NL2E, vba[n][2 * h + 1] * NL2E}; bi2[2 * n + h] = (f32x2){vbi[n][2 * h] * NL2E, vbi[n][2 * h + 1] * NL2E};
                sp2[2 * n + h] = (f32x2){vsp[n][2 * h] * (2.0f * NL2E), vsp[n][2 * h + 1] * (2.0f * NL2E)}; }
        const f32x2 nl2 = {NL2E, NL2E}, one2 = {1.0f, 1.0f};
#pragma unroll
        for (int ai = 0; ai < 2; ++ai)
#pragma unroll
            for (int m = 0; m < 4; ++m) { const unsigned off = (unsigned)(row0 + ai * 128 + m * 16) * DM + ch0;
                const v4u xv = xw[ai][m]; const unsigned xq[4] = {xv.x, xv.y, xv.z, xv.w};
                unsigned ro[4], bo[4];
#pragma unroll
                for (int n = 0; n < 2; ++n)
#pragma unroll
                    for (int h = 0; h < 2; ++h) { const int p = 2 * n + h;
                        const f32x2 ar = {acc[ai][0][m][n][2 * h], acc[ai][0][m][n][2 * h + 1]}, ag = {acc[ai][1][m][n][2 * h], acc[ai][1][m][n][2 * h + 1]};
                        const f32x2 er = ar * nl2 + ba2[p], eg = ag * nl2 + bi2[p];
                        const f32x2 dr = (f32x2){__builtin_amdgcn_exp2f(er[0]), __builtin_amdgcn_exp2f(er[1])} + one2, dg = (f32x2){__builtin_amdgcn_exp2f(eg[0]), __builtin_amdgcn_exp2f(eg[1])} + one2;
                        const f32x2 r = {fast_rcp(dr[0]), fast_rcp(dr[1])}, ig = {fast_rcp(dg[0]), fast_rcp(dg[1])};
                        const f32x2 t = r * sp2[p]; const f32x2 a2 = {__builtin_amdgcn_exp2f(t[0]), __builtin_amdgcn_exp2f(t[1])};
                        const f32x2 om = one2 - a2; const f32x2 sq = {__builtin_sqrtf(fmaxf(om[0], 0.0f)), __builtin_sqrtf(fmaxf(om[1], 0.0f))};
                        const f32x2 xr2 = {bf_lo(xq[p]), bf_hi(xq[p])};
                        const f32x2 ob = sq * (ig * xr2);
                        ro[p] = __builtin_bit_cast(unsigned, __builtin_amdgcn_cvt_pknorm_u16(r[0], r[1])); bo[p] = cvt_pk_bf16(ob[0], ob[1]); }
                *(v4u*)(LAb + off) = (v4u){ro[0], ro[1], ro[2], ro[3]}; *(v4u*)(BTb + off) = (v4u){bo[0], bo[1], bo[2], bo[3]}; }
    }
};
struct EpiSwiglu {
    static constexpr bool PERM = true;
    bf16* O; int ldc; float sc;
    __device__ __forceinline__ void operator()(AccT acc, const Unit& u, int wr, int wc, int fr, int fq) const {
        const int row0 = u.pm * 256 + wr * 64 + fr, col0 = u.pn * 128 + wc * 32 + 8 * fq;
#pragma unroll
        for (int ai = 0; ai < 2; ++ai)
#pragma unroll
            for (int m = 0; m < 4; ++m) { f32x4 a, b;
#pragma unroll
                for (int e = 0; e < 4; ++e) { a[e] = silu_(acc[ai][0][m][0][e] * sc) * (acc[ai][1][m][0][e] * sc); b[e] = silu_(acc[ai][0][m][1][e] * sc) * (acc[ai][1][m][1][e] * sc); }
                *(v4u*)(O + (size_t)(row0 + ai * 128 + m * 16) * ldc + col0) = pack8(a, b); }
    }
};
struct EpiSwiglu8 {
    static constexpr bool PERM = true;
    unsigned char* O8; int ldc; float sc;
    __device__ __forceinline__ void operator()(AccT acc, const Unit& u, int wr, int wc, int fr, int fq) const {
        const int row0 = u.pm * 256 + wr * 64 + fr + (fq & 1) * 16, col0 = u.pn * 128 + wc * 32 + (fq >> 1) * 16;
        const float c1 = -1.4426950408889634f * sc, c2 = fast_rcp(sc * sc);
        const f32x2 c1v = {c1, c1}, c2v = {c2, c2};
#pragma unroll
        for (int ai = 0; ai < 2; ++ai)
#pragma unroll
            for (int mp = 0; mp < 2; ++mp) { unsigned wv[2][2];
#pragma unroll
                for (int mm = 0; mm < 2; ++mm) { const int m = 2 * mp + mm; f32x2 o[4];
#pragma unroll
                    for (int n = 0; n < 2; ++n)
#pragma unroll
                        for (int h = 0; h < 2; ++h) {
                            const f32x2 g = {acc[ai][0][m][n][2 * h], acc[ai][0][m][n][2 * h + 1]}, uu = {acc[ai][1][m][n][2 * h], acc[ai][1][m][n][2 * h + 1]};
                            const f32x2 x = g * c1v; const f32x2 e = {__builtin_amdgcn_exp2f(x[0]), __builtin_amdgcn_exp2f(x[1])};
                            const f32x2 d = e * c2v + c2v; const f32x2 r = {fast_rcp(d[0]), fast_rcp(d[1])};
                            o[2 * n + h] = (g * uu) * r; }
                    int w0 = __builtin_amdgcn_cvt_pk_fp8_f32(o[0][0], o[0][1], 0, false); w0 = __builtin_amdgcn_cvt_pk_fp8_f32(o[1][0], o[1][1], w0, true);
                    int w1 = __builtin_amdgcn_cvt_pk_fp8_f32(o[2][0], o[2][1], 0, false); w1 = __builtin_amdgcn_cvt_pk_fp8_f32(o[3][0], o[3][1], w1, true);
                    wv[mm][0] = (unsigned)w0; wv[mm][1] = (unsigned)w1; }
                asm volatile("s_nop 1\n\tv_permlane16_swap_b32 %0, %2\n\tv_permlane16_swap_b32 %1, %3\n\ts_nop 1" : "+v"(wv[0][0]), "+v"(wv[0][1]), "+v"(wv[1][0]), "+v"(wv[1][1]));
                *(v4u*)(O8 + (size_t)(row0 + ai * 128 + mp * 32) * ldc + col0) = (v4u){wv[0][0], wv[0][1], wv[1][0], wv[1][1]}; }
    }
};
__device__ __forceinline__ void rope_cs(int pos, float (&co)[8], float (&si)[8]) {
    constexpr float IR[8] = {1.591549431e-01f, 3.086376340e-02f, 5.985185713e-03f, 1.160663641e-03f, 2.250790790e-04f, 4.364795279e-05f, 8.464330808e-06f, 1.641426263e-06f};
    const float p = (float)pos;
#pragma unroll
    for (int k = 0; k < 8; ++k) { const float r = __builtin_amdgcn_fractf(p * IR[k]); co[k] = __builtin_amdgcn_cosf(r); si[k] = __builtin_amdgcn_sinf(r); }
}
__device__ __forceinline__ void rope8(f32x4& a, f32x4& b, bool lowhalf, bool active, const float (&co)[8], const float (&si)[8]) {
    f32x4 pa, pb;
#pragma unroll
    for (int e = 0; e < 4; ++e) { pa[e] = __shfl_xor(a[e], 16); pb[e] = __shfl_xor(b[e], 16); }
    if (active) {
#pragma unroll
        for (int e = 0; e < 4; ++e) {
            if (lowhalf) { a[e] = a[e] * co[e] - pa[e] * si[e]; b[e] = b[e] * co[4 + e] - pb[e] * si[4 + e]; }
            else { a[e] = a[e] * co[e] + pa[e] * si[e]; b[e] = b[e] * co[4 + e] + pb[e] * si[4 + e]; }
        }
    }
}
struct EpiKV {
    static constexpr bool PERM = true;
    bf16* KVT; float sc;
    __device__ __forceinline__ void operator()(AccT acc, const Unit& u, int wr, int wc, int fr, int fq) const {
        const int j = u.pn; const bool dorope = (j == 2 || j == 4) && ((wc & 1) == 0);
        const int row0 = u.pm * 256 + wr * 64 + fr, d0 = 32 * (wc & 1) + 8 * fq;
#pragma unroll
        for (int ai = 0; ai < 2; ++ai)
#pragma unroll
            for (int m = 0; m < 4; ++m) { const int row = row0 + ai * 128 + m * 16, b = row >> 11, s = row & 2047;
                float co[8], si[8]; if (dorope) rope_cs(s, co, si);
#pragma unroll
                for (int bj = 0; bj < 2; ++bj) { const int g = 2 * bj + (wc >> 1);
                    f32x4 a = acc[ai][bj][m][0] * sc, bq = acc[ai][bj][m][1] * sc;
                    if (dorope) rope8(a, bq, fq == 0, fq < 2, co, si);
                    *(v4u*)(KVT + ((size_t)((j * BATCH + b) * NKV + g) * SEQ + s) * HD + d0) = pack8(a, bq); } }
    }
};
constexpr float QSCALE = 0.125f * 1.4426950408889634f;
struct EpiQG {
    static constexpr bool PERM = true;
    bf16* Q; bf16* QR; float* GT; float sc;
    __device__ __forceinline__ void operator()(AccT acc, const Unit& u, int wr, int wc, int fr, int fq) const {
        const int row0 = u.pm * 256 + wr * 64 + fr;
        if (u.pn < 4) {
            const int col0 = u.pn * 256 + wc * 32 + 8 * fq; const bool dorope = (wc & 1) == 0;
#pragma unroll
            for (int ai = 0; ai < 2; ++ai)
#pragma unroll
                for (int m = 0; m < 4; ++m) { const int row = row0 + ai * 128 + m * 16, s = row & 2047;
                    float co[8], si[8]; if (dorope) rope_cs(s, co, si);
#pragma unroll
                    for (int bj = 0; bj < 2; ++bj) { f32x4 a = acc[ai][bj][m][0] * (QSCALE * sc), bq = acc[ai][bj][m][1] * (QSCALE * sc);
                        const size_t off = (size_t)row * DM + col0 + bj * 128;
                        *(v4u*)(Q + off) = pack8(a, bq);
                        if (dorope) rope8(a, bq, fq == 0, fq < 2, co, si);
                        *(v4u*)(QR + off) = pack8(a, bq); } }
        } else {
            const int col0 = wc * 32 + 8 * fq;
            if (col0 < 48) {
#pragma unroll
                for (int ai = 0; ai < 2; ++ai)
#pragma unroll
                    for (int m = 0; m < 4; ++m) { const int row = row0 + ai * 128 + m * 16; f32x4 a = acc[ai][0][m][0], bq = acc[ai][0][m][1];
#pragma unroll
                        for (int e = 0; e < 4; ++e) { a[e] = sigmoidf_(a[e] * sc); bq[e] = sigmoidf_(bq[e] * sc); }
                        *(f32x4*)(GT + (size_t)row * 64 + col0) = a; *(f32x4*)(GT + (size_t)row * 64 + col0 + 4) = bq; }
            }
        }
    }
};
struct EpiCmp {
    static constexpr bool PERM = true;
    bf16* CH; const float* bias;
    __device__ __forceinline__ void operator()(AccT acc, const Unit& u, int wr, int wc, int fr, int fq) const {
        const int j = u.pn, row0 = u.pm * 256 + wr * 64 + fr, col0 = wc * 32 + 8 * fq;
        bf16* O = CH + (size_t)j * 8192 * 256;
        float bv[2][8];
#pragma unroll
        for (int bj = 0; bj < 2; ++bj)
#pragma unroll
            for (int e = 0; e < 8; ++e) bv[bj][e] = bias[j * 256 + bj * 128 + col0 + e];
#pragma unroll
        for (int ai = 0; ai < 2; ++ai)
#pragma unroll
            for (int m = 0; m < 4; ++m) { bf16* rowp = O + (size_t)(row0 + ai * 128 + m * 16) * 256 + col0;
#pragma unroll
                for (int bj = 0; bj < 2; ++bj) { f32x4 a = acc[ai][bj][m][0], b = acc[ai][bj][m][1];
#pragma unroll
                    for (int e = 0; e < 4; ++e) { a[e] = gelu_tanh(a[e] + bv[bj][e]); b[e] = gelu_tanh(b[e] + bv[bj][4 + e]); }
                    *(v4u*)(rowp + bj * 128) = pack8(a, b); } }
    }
};
#define XB_TMO      128
#define XB_XCNT(j)  (256  + 64 * (j))
#define XB_XSUB(j)  (1280 + 64 * (j))
#define XB_XGEN(j)  (2304 + 64 * (j))
#define XB_TOP      3328
#define XB_TOPGEN   3392
#define XCD_BAR_WORDS 3456
#define XB_SPIN_CAP (1u << 18)
__device__ __forceinline__ unsigned xb_ld(unsigned* p)              { return __hip_atomic_load(p, __ATOMIC_RELAXED, __HIP_MEMORY_SCOPE_AGENT); }
__device__ __forceinline__ unsigned xb_add(unsigned* p, unsigned v) { return __hip_atomic_fetch_add(p, v, __ATOMIC_RELAXED, __HIP_MEMORY_SCOPE_AGENT); }
__device__ __forceinline__ unsigned xb_xcc_id() { return (unsigned)__builtin_amdgcn_s_getreg((3 << 11) | 20) & 0xFu; }
#define XB_SPIN(cond, bar) do { unsigned _sp = 0; while (cond) { __builtin_amdgcn_s_sleep(1); \
    if ((++_sp & 255u) == 0u) { if (xb_ld(&(bar)[XB_TMO])) break; if (_sp > XB_SPIN_CAP) { atomicAdd(&(bar)[XB_TMO], 1u); break; } } } } while (0)
struct XcdBarrier { unsigned* bar; unsigned x; volatile LAS unsigned* st; };
__device__ __forceinline__ XcdBarrier xcd_barrier_post(unsigned* bar, volatile LAS unsigned* st) {
    XcdBarrier b; b.bar = bar; b.x = (unsigned)__builtin_amdgcn_readfirstlane((int)xb_xcc_id()); b.st = st;
    if (threadIdx.x == 0) st[3] = xb_add(&bar[XB_XCNT(b.x)], 1u);
    return b;
}
__device__ __forceinline__ void xcd_barrier_complete(unsigned* bar, unsigned x, unsigned& nloc, unsigned& nx, unsigned& uni) {
    const unsigned G = gridDim.x * gridDim.y * gridDim.z;
    unsigned sum, cnt, mine, sp = 0u, u8;
    for (;;) {
        sum = 0u; cnt = 0u; mine = 0u; u8 = 1u;
#pragma unroll
        for (unsigned j = 0; j < 16; ++j) { const unsigned c = xb_ld(&bar[XB_XCNT(j)]); sum += c; cnt += (c > 0u) ? 1u : 0u; mine = (j == x) ? c : mine; u8 &= (c == (j < 8u ? 32u : 0u)) ? 1u : 0u; }
        if (sum == G) break;
        __builtin_amdgcn_s_sleep(1);
        if ((++sp & 255u) == 0u) { if (xb_ld(&bar[XB_TMO])) break; if (sp > XB_SPIN_CAP) { atomicAdd(&bar[XB_TMO], 1u); break; } }
    }
    nloc = mine > 0u ? mine : 1u; nx = cnt > 0u ? cnt : 1u; uni = (sum == G) ? u8 : 0u;
}
__device__ __forceinline__ void xcd_barrier(const XcdBarrier& b) {
    asm volatile("s_waitcnt vmcnt(0)" ::: "memory");
    __syncthreads();
    if (threadIdx.x == 0) {
        unsigned long zb_ = 0; unsigned bx_ = b.x; asm volatile("" : "+s"(zb_), "+s"(bx_)); unsigned* bar = b.bar + zb_;
        __builtin_amdgcn_s_waitcnt(0);
        unsigned nloc = b.st[0], nx = b.st[1];
        if (nloc == 0u) { unsigned uni_; xcd_barrier_complete(bar, bx_, nloc, nx, uni_); b.st[0] = nloc; b.st[1] = nx; b.st[2] = uni_; }
        const unsigned old = xb_add(&bar[XB_XSUB(bx_)], 1u);
        const unsigned gen = old / nloc;
        if (old + 1u == (gen + 1u) * nloc) {
            __builtin_amdgcn_fence(__ATOMIC_RELEASE, "agent");
            asm volatile("s_waitcnt vmcnt(0)" ::: "memory");
            const unsigned og = xb_add(&bar[XB_TOP], 1u);
            const unsigned tg = og / nx;
            if (og + 1u == (tg + 1u) * nx) xb_add(&bar[XB_TOPGEN], 1u);
            else XB_SPIN(xb_ld(&bar[XB_TOPGEN]) == tg, bar);
            __builtin_amdgcn_fence(__ATOMIC_ACQUIRE, "agent");
            xb_add(&bar[XB_XGEN(bx_)], 1u);
            asm volatile("s_waitcnt vmcnt(0)" ::: "memory");
        } else {
            XB_SPIN(xb_ld(&bar[XB_XGEN(bx_)]) == gen, bar);
            __builtin_amdgcn_fence(__ATOMIC_ACQUIRE, "agent");
            asm volatile("s_waitcnt vmcnt(0)" ::: "memory");
        }
    }
    __syncthreads();
}

__device__ __forceinline__ void xcd_barrier_local(const XcdBarrier& b) {
    asm volatile("s_waitcnt vmcnt(0)" ::: "memory");
    __syncthreads();
    if (threadIdx.x == 0) {
        unsigned long zb_ = 0; unsigned bx_ = b.x; asm volatile("" : "+s"(zb_), "+s"(bx_)); unsigned* bar = b.bar + zb_;
        __builtin_amdgcn_s_waitcnt(0);
        const unsigned nloc = b.st[0];
        const unsigned old = xb_add(&bar[XB_XSUB(bx_)], 1u);
        const unsigned gen = old / nloc;
        if (old + 1u == (gen + 1u) * nloc) {
            __builtin_amdgcn_fence(__ATOMIC_ACQUIRE, "agent");
            xb_add(&bar[XB_XGEN(bx_)], 1u);
            asm volatile("s_waitcnt vmcnt(0)" ::: "memory");
        } else {
            XB_SPIN(xb_ld(&bar[XB_XGEN(bx_)]) == gen, bar);
            __builtin_amdgcn_fence(__ATOMIC_ACQUIRE, "agent");
            asm volatile("s_waitcnt vmcnt(0)" ::: "memory");
        }
    }
    __syncthreads();
}

struct XFam { const float* src; size_t sstride; int nmat, K, Nsrc, Ndst; unsigned char* dst; size_t dstride; int FSW; float wscale; };
__device__ __forceinline__ void xp_issue(const XFam& f, f32x4 (&v)[8], int it, bool& okn, int lane) {
    const int nkb = f.K / 64, nnb = f.Ndst / 32, per = nkb * nnb, c4 = lane & 7, kr = lane >> 3;
    const int mat = it / per, r = it % per, kb = r / nnb, nb = r % nnb, n0 = nb * 32; okn = (n0 + 4 * c4) < f.Nsrc;
    const float* W = f.src + (size_t)mat * f.sstride + (size_t)(kb * 64 + 8 * kr) * f.Nsrc + (okn ? n0 + 4 * c4 : 0);
#pragma unroll
    for (int i = 0; i < 8; ++i) v[i] = *(const f32x4*)(W + (size_t)i * f.Nsrc);
}
template <int KIND>
__device__ __forceinline__ void xp_finish(const XFam& f, const f32x4 (&w)[8], int it, bool okn, int lane, int pm) {
    constexpr int ES = KIND == 0 ? 2 : 1;
    const int nkb = f.K / 64, nnb = f.Ndst / 32, per = nkb * nnb, c4 = lane & 7, kr = lane >> 3;
    const int mat = it / per, r = it % per, kb = r / nnb, nb = r % nnb, n0 = nb * 32, k0 = kb * 64;
    size_t drow0 = n0;
    if (f.FSW > 0) { const int isu = n0 >= f.FSW, j = n0 - (isu ? f.FSW : 0); drow0 = (size_t)(j / 128) * 256 + (isu ? 128 : 0) + (j % 128); }
    const float sc = (okn && pm != 2) ? (KIND == 0 ? 1.0f : f.wscale) : 0.0f;
    unsigned char* D = f.dst + ((size_t)mat * f.dstride + (drow0 + 4 * c4) * (size_t)f.K + k0 + 8 * kr) * ES;
#pragma unroll
    for (int j = 0; j < 4; ++j) { unsigned char* o = D + (size_t)j * f.K * ES;
        if (KIND == 0) { v4u q; q.x = pk2(w[0][j] * sc, w[1][j] * sc); q.y = pk2(w[2][j] * sc, w[3][j] * sc); q.z = pk2(w[4][j] * sc, w[5][j] * sc); q.w = pk2(w[6][j] * sc, w[7][j] * sc); *(v4u*)o = q; }
        else if (KIND == 1) {
            int w0 = __builtin_amdgcn_cvt_pk_fp8_f32(w[0][j] * sc, w[1][j] * sc, 0, false); w0 = __builtin_amdgcn_cvt_pk_fp8_f32(w[2][j] * sc, w[3][j] * sc, w0, true);
            int w1 = __builtin_amdgcn_cvt_pk_fp8_f32(w[4][j] * sc, w[5][j] * sc, 0, false); w1 = __builtin_amdgcn_cvt_pk_fp8_f32(w[6][j] * sc, w[7][j] * sc, w1, true);
            if (pm != 1) *(v2u*)o = (v2u){(unsigned)w0, (unsigned)w1}; }
        else { const unsigned w0 = pack4_i8(w[0][j], w[1][j], w[2][j], w[3][j], sc), w1 = pack4_i8(w[4][j], w[5][j], w[6][j], w[7][j], sc);
            if (pm != 1) *(v2u*)o = (v2u){w0, w1}; } }
}
template <int KIND, bool DEEP = false>
__device__ __forceinline__ void transpose_family_t(const float* src, size_t sstride, int nmat, int K, int Nsrc, int Ndst, unsigned char* dst, size_t dstride, int FSW, float wscale,
                                                   int gw, int NGW, int lane, int pm = 0, int rb = 0, int re = 0x7fffffff) {
    const XFam f{src, sstride, nmat, K, Nsrc, Ndst, dst, dstride, FSW, wscale};
    const int total = (K / 64) * (Ndst / 32) * nmat;
    const int it0 = gw + rb * NGW; int nr = 0;
    if (it0 < total && rb < re) { nr = (total - it0 + NGW - 1) / NGW; if (nr > re - rb) nr = re - rb; }
    if (nr <= 0) return;
    auto itc = [&](int q) { return it0 + (q < nr ? q : nr - 1) * NGW; };
    if (DEEP) {
        f32x4 v0[8], v1[8], v2[8], v3[8]; bool k0 = false, k1 = false, k2 = false, k3 = false;
        xp_issue(f, v0, itc(0), k0, lane); xp_issue(f, v1, itc(1), k1, lane); xp_issue(f, v2, itc(2), k2, lane);
        for (int q = 0; q < nr; q += 4) {
            xp_issue(f, v3, itc(q + 3), k3, lane); xp_finish<KIND>(f, v0, itc(q), k0, lane, pm);
            if (q + 1 >= nr) break;
            xp_issue(f, v0, itc(q + 4), k0, lane); xp_finish<KIND>(f, v1, itc(q + 1), k1, lane, pm);
            if (q + 2 >= nr) break;
            xp_issue(f, v1, itc(q + 5), k1, lane); xp_finish<KIND>(f, v2, itc(q + 2), k2, lane, pm);
            if (q + 3 >= nr) break;
            xp_issue(f, v2, itc(q + 6), k2, lane); xp_finish<KIND>(f, v3, itc(q + 3), k3, lane, pm);
        }
    } else {
        f32x4 va[8], vb[8]; bool oka = false, okb = false;
        xp_issue(f, va, itc(0), oka, lane);
        for (int q = 0; q < nr; q += 2) {
            xp_issue(f, vb, itc(q + 1), okb, lane); xp_finish<KIND>(f, va, itc(q), oka, lane, pm);
            if (q + 1 >= nr) break;
            xp_issue(f, va, itc(q + 2), oka, lane); xp_finish<KIND>(f, vb, itc(q + 1), okb, lane, pm);
        }
    }
}
template <bool DEEP = false> __device__ __forceinline__ void transpose_family_f8(const float* src, size_t sstride, int nmat, int K, int N, int Ndst, unsigned char* dst, size_t dstride, int FSW, float wscale, LAS float* scr, int gw, int NGW, int lane, int pm = 0, int rb = 0, int re = 0x7fffffff) {
    transpose_family_t<1, DEEP>(src, sstride, nmat, K, N, Ndst, dst, dstride, FSW, wscale, gw, NGW, lane, pm, rb, re); }
template <bool DEEP = false> __device__ __forceinline__ void transpose_family_i8(const float* src, size_t sstride, int nmat, int K, int N, int Ndst, unsigned char* dst, size_t dstride, int FSW, float wscale, LAS float* scr, int gw, int NGW, int lane, int pm = 0, int rb = 0, int re = 0x7fffffff) {
    transpose_family_t<2, DEEP>(src, sstride, nmat, K, N, Ndst, dst, dstride, FSW, wscale, gw, NGW, lane, pm, rb, re); }
__device__ __forceinline__ void transpose_family(const float* src, size_t sstride, int nmat, int K, int Nsrc, int Ndst, bf16* dst, size_t dstride, int FSW, LAS float* scr, int gw, int NGW, int lane) {
    transpose_family_t<0>(src, sstride, nmat, K, Nsrc, Ndst, (unsigned char*)dst, dstride, FSW, 1.0f, gw, NGW, lane); }
#define FRESH_TID() int lane_f; asm volatile("v_mbcnt_lo_u32_b32 %0, -1, 0\n\tv_mbcnt_hi_u32_b32 %0, -1, %0" : "=v"(lane_f)); const int lane = lane_f, tid = lane_f + 64 * wave; (void)lane; (void)tid
namespace nsa {
constexpr int KROW = 144;
constexpr int KT_BYTES = 64 * KROW, VT_BYTES = 8192;
constexpr int L_KC = 0, L_VC = L_KC + 2 * KT_BYTES, L_KB = L_VC + 2 * VT_BYTES, L_VB = L_KB + 2 * KT_BYTES, L_PS = L_VB + 2 * VT_BYTES;
constexpr int L_IMP = L_PS + 8 * 8 * 128 * 4, L_UNI = L_IMP + 8 * 8 * 32 * 4, L_END = L_UNI + 64;
static_assert(L_END <= RING_BYTES, "attention LDS");
constexpr float NEGB = -1e30f, LOG2E = 1.4426950408889634f;

__device__ __forceinline__ int crow(int r, int hi) { return (r & 3) + 8 * (r >> 2) + 4 * hi; }
__device__ __forceinline__ s16x4 vtr(const LAS unsigned char* p) { return __builtin_bit_cast(s16x4, __builtin_amdgcn_ds_read_tr16_b64_v4i16((LAS s16x4*)p)); }
__device__ __forceinline__ float pmax32(float v) { return fmaxf(v, __shfl_xor(v, 32)); }
__device__ __forceinline__ void headsum4(float& a0, float& a1, float& a2, float& a3) {
    a0 += dpp_f<0x128>(a0); a1 += dpp_f<0x128>(a1); a2 += dpp_f<0x128>(a2); a3 += dpp_f<0x128>(a3);
    float b0, b1, b2, b3;
    asm volatile("v_mov_b32 %4, %0\n\tv_mov_b32 %5, %1\n\tv_mov_b32 %6, %2\n\tv_mov_b32 %7, %3\n\ts_nop 1\n\t"
                 "v_permlane16_swap_b32 %0, %4\n\tv_permlane16_swap_b32 %1, %5\n\tv_permlane16_swap_b32 %2, %6\n\tv_permlane16_swap_b32 %3, %7\n\ts_nop 1"
                 : "+v"(a0), "+v"(a1), "+v"(a2), "+v"(a3), "=&v"(b0), "=&v"(b1), "=&v"(b2), "=&v"(b3));
    a0 += b0; a1 += b1; a2 += b2; a3 += b3;
}

__device__ __forceinline__ void qk_tile(f32x16& p0, f32x16& p1, const LAS unsigned char* kt, const bf16x8 (&qf)[4], int r32, int hi) {
    p0 = (f32x16){0.f, 0.f, 0.f, 0.f, 0.f, 0.f, 0.f, 0.f, 0.f, 0.f, 0.f, 0.f, 0.f, 0.f, 0.f, 0.f}; p1 = p0;
    bf16x8 k0[4], k1[4];
#pragma unroll
    for (int d0 = 0; d0 < 4; ++d0) { k0[d0] = *(const LAS bf16x8*)(kt + r32 * KROW + d0 * 32 + hi * 16); k1[d0] = *(const LAS bf16x8*)(kt + (32 + r32) * KROW + d0 * 32 + hi * 16); }
    LDS_WAIT();
#pragma unroll
    for (int d0 = 0; d0 < 4; ++d0) {
        p0 = __builtin_amdgcn_mfma_f32_32x32x16_bf16(k0[d0], qf[d0], p0, 0, 0, 0);
        p1 = __builtin_amdgcn_mfma_f32_32x32x16_bf16(k1[d0], qf[d0], p1, 0, 0, 0);
    }
}
__device__ __forceinline__ void pv_tile(f32x16 (&o)[2], const LAS unsigned char* vt, const bf16x8 (&pb)[4], int lane) {
    const int hi = lane >> 5;
    const LAS unsigned char* vp = vt + ((lane >> 4) & 1) * 32 + (lane & 3) * 8 + (4 * hi + ((lane & 15) >> 2)) * 64;
    s16x4 lo[2][4], hh[2][4];
#pragma unroll
    for (int dh = 0; dh < 2; ++dh)
#pragma unroll
        for (int ks = 0; ks < 4; ++ks) { lo[dh][ks] = vtr(vp + dh * 4096 + ks * 1024); hh[dh][ks] = vtr(vp + dh * 4096 + ks * 1024 + 512); }
    LDS_WAIT();
#pragma unroll
    for (int ks = 0; ks < 4; ++ks)
#pragma unroll
        for (int dh = 0; dh < 2; ++dh) {
            const bf16x8 vf = (bf16x8){lo[dh][ks][0], lo[dh][ks][1], lo[dh][ks][2], lo[dh][ks][3], hh[dh][ks][0], hh[dh][ks][1], hh[dh][ks][2], hh[dh][ks][3]};
            o[dh] = __builtin_amdgcn_mfma_f32_32x32x16_bf16(vf, pb[ks], o[dh], 0, 0, 0);
        }
}
__device__ __forceinline__ void pack_p(bf16x8 (&pb)[4], const f32x16& p0, const f32x16& p1) {
    v4u w;
    w.x = cvt_pk_bf16(p0[0], p0[1]); w.y = cvt_pk_bf16(p0[2], p0[3]); w.z = cvt_pk_bf16(p0[4], p0[5]); w.w = cvt_pk_bf16(p0[6], p0[7]); pb[0] = __builtin_bit_cast(bf16x8, w);
    w.x = cvt_pk_bf16(p0[8], p0[9]); w.y = cvt_pk_bf16(p0[10], p0[11]); w.z = cvt_pk_bf16(p0[12], p0[13]); w.w = cvt_pk_bf16(p0[14], p0[15]); pb[1] = __builtin_bit_cast(bf16x8, w);
    w.x = cvt_pk_bf16(p1[0], p1[1]); w.y = cvt_pk_bf16(p1[2], p1[3]); w.z = cvt_pk_bf16(p1[4], p1[5]); w.w = cvt_pk_bf16(p1[6], p1[7]); pb[2] = __builtin_bit_cast(bf16x8, w);
    w.x = cvt_pk_bf16(p1[8], p1[9]); w.y = cvt_pk_bf16(p1[10], p1[11]); w.z = cvt_pk_bf16(p1[12], p1[13]); w.w = cvt_pk_bf16(p1[14], p1[15]); pb[3] = __builtin_bit_cast(bf16x8, w);
}
__device__ __forceinline__ void put_k(LAS unsigned char* kt, v4u v, int tid) { *(LAS v4u*)(kt + (tid >> 3) * KROW + (tid & 7) * 16) = v; }
__device__ __forceinline__ void put_v(LAS unsigned char* vt, v4u v, int tid) { const int kv = tid >> 3, ch = tid & 7; *(LAS v4u*)(vt + (ch >> 2) * 4096 + (kv >> 4) * 1024 + (kv & 15) * 64 + (ch & 3) * 16) = v; }

constexpr float BIG = 1e30f;
template <int ABL> __device__ __forceinline__ void tile_step(const bool MLO, const bool MCA, const LAS unsigned char* kt, const LAS unsigned char* vt, const bf16x8 (&qf)[4], int kv0, int tpos, bool rowok,
                                          float& l, f32x16 (&o)[2], int lane) {
    const int r32 = lane & 31, hi = lane >> 5;
    f32x16 p0, p1;
    if (ABL == 3) { p0 = o[0]; p1 = o[1]; } else qk_tile(p0, p1, kt, qf, r32, hi);
    if (MLO || MCA) {
#pragma unroll
        for (int r = 0; r < 16; ++r) {
            const int ka = kv0 + crow(r, hi), kb = ka + 32;
            const bool oka = (!MCA || ka <= tpos) && (!MLO || ka > tpos - 256), okb = (!MCA || kb <= tpos) && (!MLO || kb > tpos - 256);
            p0[r] = oka ? p0[r] : -BIG; p1[r] = okb ? p1[r] : -BIG;
        }
    }
    float ls = 0.f;
    if (ABL != 2) {
#pragma unroll
    for (int r = 0; r < 16; ++r) { p0[r] = __builtin_amdgcn_exp2f(p0[r]); p1[r] = __builtin_amdgcn_exp2f(p1[r]); }
    { const f32x16 ps = p0 + p1;
      const f32x4 q4 = (__builtin_shufflevector(ps, ps, 0, 1, 2, 3) + __builtin_shufflevector(ps, ps, 4, 5, 6, 7)) + (__builtin_shufflevector(ps, ps, 8, 9, 10, 11) + __builtin_shufflevector(ps, ps, 12, 13, 14, 15));
      ls = (q4[0] + q4[1]) + (q4[2] + q4[3]); } }
    bf16x8 pb[4]; pack_p(pb, p0, p1);
    if (!__all(rowok)) {
        const bf16x8 z8 = (bf16x8){0, 0, 0, 0, 0, 0, 0, 0};
#pragma unroll
        for (int k = 0; k < 4; ++k) pb[k] = rowok ? pb[k] : z8;
        ls = rowok ? ls : 0.f;
    }
    l += ls;
    if (ABL == 1) { o[0][0] += __builtin_bit_cast(float, (int)pb[0][0] + (int)pb[1][1] + (int)pb[2][2] + (int)pb[3][3]); } else pv_tile(o, vt, pb, lane);
}

template <int ABL> __device__ __forceinline__ void attn_unit(LAS unsigned char* lds, int b, int g, int qt, const bf16* Q, const bf16* QR, const float* GT, const bf16* KVT, const bf16* KCMP, bf16* O, float* DBGP, const int wave) {
    FRESH_TID(); const int r32 = lane & 31, hi = lane >> 5; const int wid = wave;
    const int bg = b * NKV + g;
    const int tl = r32 & 7, hh = r32 >> 3;
    const int tpos = qt * 64 + wid * 8 + tl;
    const unsigned trow = (unsigned)b * SEQ + tpos;
    const int head = g * HPG + hh;
    const bf16* kc = KCMP + (size_t)bg * 128 * 64; const bf16* vc = KCMP + (size_t)(64 + bg) * 128 * 64;
    const bf16* kslc = KVT + (size_t)((2 * BATCH + b) * NKV + g) * SEQ * HD; const bf16* vslc = KVT + (size_t)((3 * BATCH + b) * NKV + g) * SEQ * HD;
    const bf16* kwin = KVT + (size_t)((4 * BATCH + b) * NKV + g) * SEQ * HD; const bf16* vwin = KVT + (size_t)((5 * BATCH + b) * NKV + g) * SEQ * HD;
    LAS unsigned char* const KC = lds + L_KC; LAS unsigned char* const VC = lds + L_VC; LAS unsigned char* const KB = lds + L_KB; LAS unsigned char* const VB = lds + L_VB;
    LAS float* const PS = (LAS float*)(lds + L_PS) + wid * 8 * 128; LAS float* const IMP = (LAS float*)(lds + L_IMP) + wid * 8 * 32; LAS unsigned* const UNI = (LAS unsigned*)(lds + L_UNI);

    const bool two = qt >= 16;
    const int jw0 = qt >= 4 ? qt - 4 : 0, nwin = qt - jw0 + 1;
    {
        const v4u a0 = *(const v4u*)(kc + tid * 8), c0 = *(const v4u*)(vc + tid * 8);
        put_k(KC, a0, tid); put_v(VC, c0, tid);
        if (two) { const v4u a1 = *(const v4u*)(kc + 4096 + tid * 8), c1 = *(const v4u*)(vc + 4096 + tid * 8); put_k(KC + KT_BYTES, a1, tid); put_v(VC + VT_BYTES, c1, tid); }
    }
    v4u nk = *(const v4u*)(kwin + (unsigned)(jw0 * 4096 + tid * 8)), nv = *(const v4u*)(vwin + (unsigned)(jw0 * 4096 + tid * 8));
    v4u nk1, nv1;
    if (nwin >= 2) { nk1 = *(const v4u*)(kwin + (unsigned)((jw0 + 1) * 4096 + tid * 8)); nv1 = *(const v4u*)(vwin + (unsigned)((jw0 + 1) * 4096 + tid * 8)); }
    else { nk1 = *(const v4u*)(kslc + (unsigned)(tid * 8)); nv1 = *(const v4u*)(vslc + (unsigned)(tid * 8)); }
    const float g_cmp = GT[trow * 64 + head * 3 + 0], g_slc = GT[trow * 64 + head * 3 + 1], g_win = GT[trow * 64 + head * 3 + 2];
    bf16x8 qf[4];
#pragma unroll
    for (int d0 = 0; d0 < 4; ++d0) qf[d0] = *(const bf16x8*)(Q + trow * DM + head * HD + d0 * 16 + hi * 8);
    LDS_WAIT(); __syncthreads();

    f32x16 of[2];
    unsigned selmask;
    unsigned uni_w;
    {
        f32x16 s0, s1, s2, s3; qk_tile(s0, s1, KC, qf, r32, hi);
        if (two) qk_tile(s2, s3, KC + KT_BYTES, qf, r32, hi);
        else {
#pragma unroll
            for (int r = 0; r < 16; ++r) { s2[r] = NEGB; s3[r] = NEGB; } }
        const int cmax = tpos >= 31 ? ((tpos - 31) >> 4) : -1;
        float mx = NEGB;
#pragma unroll
        for (int r = 0; r < 16; ++r) { const int c = crow(r, hi);
            s0[r] = (c <= cmax) ? s0[r] : NEGB; s1[r] = (c + 32 <= cmax) ? s1[r] : NEGB; s2[r] = (c + 64 <= cmax) ? s2[r] : NEGB; s3[r] = (c + 96 <= cmax) ? s3[r] : NEGB;
            mx = fmaxf(fmaxf(mx, fmaxf(s0[r], s1[r])), fmaxf(s2[r], s3[r])); }
        mx = pmax32(mx);
        float ls = 0.f;
#pragma unroll
        for (int r = 0; r < 16; ++r) { const int c = crow(r, hi);
            s0[r] = __builtin_amdgcn_exp2f(s0[r] - mx); s1[r] = __builtin_amdgcn_exp2f(s1[r] - mx); ls += s0[r] + s1[r]; }
        if (two) {
#pragma unroll
            for (int r = 0; r < 16; ++r) { s2[r] = __builtin_amdgcn_exp2f(s2[r] - mx); s3[r] = __builtin_amdgcn_exp2f(s3[r] - mx); ls += s2[r] + s3[r]; }
        } else {
#pragma unroll
            for (int r = 0; r < 16; ++r) { s2[r] = 0.f; s3[r] = 0.f; } }
        ls += __shfl_xor(ls, 32);
        const float inv = cmax >= 0 ? 1.0f / ls : 0.f;
        s0 *= inv; s1 *= inv; s2 *= inv; s3 *= inv;
#pragma unroll
        for (int q = 0; q < 4; ++q) { const int c = 8 * q + 4 * hi;
            f32x4 t0 = (f32x4){s0[4 * q], s0[4 * q + 1], s0[4 * q + 2], s0[4 * q + 3]}, t1 = (f32x4){s1[4 * q], s1[4 * q + 1], s1[4 * q + 2], s1[4 * q + 3]};
            f32x4 t2 = (f32x4){s2[4 * q], s2[4 * q + 1], s2[4 * q + 2], s2[4 * q + 3]}, t3 = (f32x4){s3[4 * q], s3[4 * q + 1], s3[4 * q + 2], s3[4 * q + 3]};
#pragma unroll
            for (int e = 0; e < 4; ++e) { float x0 = t0[e], x1 = t1[e], x2 = t2[e], x3 = t3[e]; headsum4(x0, x1, x2, x3); t0[e] = x0; t1[e] = x1; t2[e] = x2; t3[e] = x3; }
            if (hh == 0) { *(LAS f32x4*)(PS + tl * 128 + c) = t0; *(LAS f32x4*)(PS + tl * 128 + c + 32) = t1; *(LAS f32x4*)(PS + tl * 128 + c + 64) = t2; *(LAS f32x4*)(PS + tl * 128 + c + 96) = t3; } }
        f32x16 oc[2]; oc[0] = (f32x16){0.f, 0.f, 0.f, 0.f, 0.f, 0.f, 0.f, 0.f, 0.f, 0.f, 0.f, 0.f, 0.f, 0.f, 0.f, 0.f}; oc[1] = oc[0];
        { bf16x8 pb[4]; pack_p(pb, s0, s1); pv_tile(oc, VC, pb, lane); if (two) { pack_p(pb, s2, s3); pv_tile(oc, VC + VT_BYTES, pb, lane); } }
#pragma unroll
        for (int r = 0; r < 16; ++r) { of[0][r] = g_cmp * oc[0][r]; of[1][r] = g_cmp * oc[1][r]; }
        LDS_WAIT(); asm volatile("" ::: "memory");
        const int st = lane >> 3, jq = lane & 7, spos = qt * 64 + wid * 8 + st, cur = spos >> 6;
        float imp[4];
#pragma unroll
        for (int i = 0; i < 4; ++i) { const int j = jq + 8 * i; const f32x4 pv4 = *(const LAS f32x4*)(PS + st * 128 + 4 * j);
            float a = (j > 0) ? PS[st * 128 + 4 * j - 1] : 0.f; a += pv4[0]; a += pv4[1]; a += pv4[2]; a += pv4[3];
            imp[i] = a; IMP[st * 32 + j] = a; }
        LDS_WAIT(); asm volatile("" ::: "memory");
        int rank[4] = {0, 0, 0, 0};
        f32x4 iv[8];
#pragma unroll
        for (int q = 0; q < 8; ++q) iv[q] = *(const LAS f32x4*)(IMP + st * 32 + 4 * q);
#pragma unroll
        for (int j2 = 1; j2 < 32; ++j2) if (j2 <= qt - 2) { const float v2 = iv[j2 >> 2][j2 & 3];
#pragma unroll
            for (int i = 0; i < 4; ++i) { const int j = jq + 8 * i; rank[i] += (v2 > imp[i] || (v2 == imp[i] && j2 < j)) ? 1 : 0; } }
        unsigned long long bal[4];
#pragma unroll
        for (int i = 0; i < 4; ++i) { const int j = jq + 8 * i; const bool sel = (j == 0) || (j == cur) || (j == cur - 1) || (j >= 1 && j <= cur - 2 && rank[i] < 5); bal[i] = __ballot(sel); }
        selmask = 0u; uni_w = 0u;
#pragma unroll
        for (int i = 0; i < 4; ++i) { selmask |= ((unsigned)(bal[i] >> (8 * tl)) & 0xffu) << (8 * i);
#pragma unroll
            for (int t8 = 0; t8 < 8; ++t8) uni_w |= ((unsigned)(bal[i] >> (8 * t8)) & 0xffu) << (8 * i); }
        uni_w = __builtin_amdgcn_readfirstlane(uni_w);
        if (lane == 0) UNI[wid] = uni_w;
    }
#pragma unroll
    for (int d0 = 0; d0 < 4; ++d0) qf[d0] = *(const bf16x8*)(QR + trow * DM + head * HD + d0 * 16 + hi * 8);
    put_k(KB, nk, tid); put_v(VB, nv, tid); put_k(KB + KT_BYTES, nk1, tid); put_v(VB + VT_BYTES, nv1, tid);
    LDS_WAIT(); __syncthreads();
    unsigned uni = 0u;
#pragma unroll
    for (int w = 0; w < 8; ++w) uni |= UNI[w];
    uni = __builtin_amdgcn_readfirstlane(uni);
    const int nslc = __builtin_popcount(uni), ntile = nwin + nslc;
    float l = 0.f; f32x16 o[2]; o[0] = (f32x16){0.f, 0.f, 0.f, 0.f, 0.f, 0.f, 0.f, 0.f, 0.f, 0.f, 0.f, 0.f, 0.f, 0.f, 0.f, 0.f}; o[1] = o[0];
    unsigned rem = uni; if (nwin == 1) rem &= rem - 1u;
    int blkA = jw0, blkB = (nwin >= 2) ? jw0 + 1 : 0, blkC = 0, blkD = 0;
    const int ngrp = (ntile + 1) >> 1;
    for (int g2 = 0; g2 < ngrp; ++g2) {
        const int i0 = 2 * g2, gb = g2 & 1;
        LAS unsigned char* const kg = gb ? KC : KB; LAS unsigned char* const vg = gb ? VC : VB;
        LAS unsigned char* const kn = gb ? KB : KC; LAS unsigned char* const vn = gb ? VB : VC;
        const bool hasC = i0 + 2 < ntile, hasD = i0 + 3 < ntile;
        if (hasC) { const bool w = (i0 + 2) < nwin; if (w) blkC = jw0 + i0 + 2; else { blkC = __builtin_ctz(rem); rem &= rem - 1u; }
            nk = *(const v4u*)((w ? kwin : kslc) + (unsigned)(blkC * 4096 + tid * 8)); nv = *(const v4u*)((w ? vwin : vslc) + (unsigned)(blkC * 4096 + tid * 8)); }
        if (hasD) { const bool w = (i0 + 3) < nwin; if (w) blkD = jw0 + i0 + 3; else { blkD = __builtin_ctz(rem); rem &= rem - 1u; }
            nk1 = *(const v4u*)((w ? kwin : kslc) + (unsigned)(blkD * 4096 + tid * 8)); nv1 = *(const v4u*)((w ? vwin : vslc) + (unsigned)(blkD * 4096 + tid * 8)); }
#pragma unroll
        for (int s2 = 0; s2 < 2; ++s2) { const int i = i0 + s2; if (i < ntile) {
            const int blk = s2 ? blkB : blkA;
            const bool isw = i < nwin;
            const bool need = isw || (((uni_w >> blk) & 1u) != 0u);
            const bool lo = isw && (qt >= 4) && (i == 0), ca = isw ? (i == nwin - 1) : (blk == qt);
            const bool rowok = isw || (((selmask >> blk) & 1u) != 0u);
            if (need) tile_step<ABL>(lo, ca, kg + s2 * KT_BYTES, vg + s2 * VT_BYTES, qf, blk * 64, tpos, rowok, l, o, lane);
            if (i == nwin - 1 || i == ntile - 1) {
                float lt = l + __shfl_xor(l, 32); const float gsc = ((i == nwin - 1) ? g_win : g_slc) / lt;
#pragma unroll
                for (int r = 0; r < 16; ++r) { of[0][r] += gsc * o[0][r]; of[1][r] += gsc * o[1][r]; o[0][r] = 0.f; o[1][r] = 0.f; }
                l = 0.f;
            } } }
        if (hasC) { put_k(kn, nk, tid); put_v(vn, nv, tid); }
        if (hasD) { put_k(kn + KT_BYTES, nk1, tid); put_v(vn + VT_BYTES, nv1, tid); }
        blkA = blkC; blkB = blkD;
        LDS_WAIT(); __syncthreads();
    }
#ifdef DBG_ATTN_STAT
    { float st_ = 0.f; DBG_ATTN_STAT; st_ = wave_sum(st_); if (lane == 0) atomicAdd(DBGP, st_); }
#endif
    { LAS unsigned char* const stg = (LAS unsigned char*)PS;
#pragma unroll
      for (int dh = 0; dh < 2; ++dh)
#pragma unroll
        for (int k = 0; k < 4; ++k) {
            int w = __builtin_amdgcn_cvt_pk_fp8_f32(of[dh][4 * k], of[dh][4 * k + 1], 0, false); w = __builtin_amdgcn_cvt_pk_fp8_f32(of[dh][4 * k + 2], of[dh][4 * k + 3], w, true);
            *(LAS unsigned*)(stg + tl * 256 + hh * 64 + 32 * dh + 8 * k + 4 * hi) = (unsigned)w; }
      LDS_WAIT(); asm volatile("" ::: "memory");
      const int tk = lane >> 3, chn = lane & 7;
      const v4u a0 = *(const LAS v4u*)(stg + tk * 256 + chn * 32), a1 = *(const LAS v4u*)(stg + tk * 256 + chn * 32 + 16);
      unsigned char* op = (unsigned char*)O + ((size_t)b * SEQ + qt * 64 + wid * 8 + tk) * DM + g * (HPG * HD) + chn * 32;
      *(v4u*)op = a0; *(v4u*)(op + 16) = a1;
      LDS_WAIT(); asm volatile("" ::: "memory"); }
}
}
#ifndef FFN_DN_BF16
#define FFN_DN_F8 1
#else
#error "the bf16 FFN-down option no longer fits: ACT lives in the 88 MiB free part of WS_HF"
#endif
#ifndef OUTPROJ_BF16
#define OUTPROJ_F8 1
#endif
#ifndef LN_DUMMY_OUT
#define LN_DUMMY_OUT ((bf16*)(A0.ws + WS_HF))
#endif
#ifndef MOE_W_EARLY
#define MOE_W_LATE 1
#endif
#ifdef MOE_W_LATE
#define MOE_PRO_MATS 8
#else
#define MOE_PRO_MATS 16
#endif
#ifndef REP0
#define REP0 1
#endif
#ifndef REP1
#define REP1 1
#endif
#ifndef REP2
#define REP2 1
#endif
#ifndef REP3
#define REP3 1
#endif
#ifndef REP4
#define REP4 1
#endif
#ifndef REP5
#define REP5 1
#endif
#ifndef REP6
#define REP6 1
#endif
#ifndef REP7
#define REP7 1
#endif
struct KArgs {
    const float* x; const float* ln_g; const float* ln_b; const float* lru_w_in; const float* lru_conv_w; const float* lru_conv_b; const float* lru_w_a; const float* lru_b_a;
    const float* lru_w_i; const float* lru_b_i; const float* lru_lambda; const float* lru_w_out; const float* nsa_w_kv; const float* nsa_cmp_pos; const float* nsa_cmp_w1;
    const float* nsa_cmp_w2; const float* nsa_w_qg; const float* nsa_w_o; const float* ffn_w_gu; const float* ffn_w_down; const float* moe_w_router; const float* moe_w_gu;
    const float* moe_w_down; float* out; unsigned char* ws;
};

typedef KArgs Args;
__device__ __forceinline__ unsigned char* launder_p(unsigned char* p) { asm volatile("" : "+s"(p)); return p; }
__device__ __forceinline__ const KArgs* launder_k(const KArgs* p) { asm volatile("" : "+s"(p)); return p; }

template <int MODE, bool ROUTER, bool RES32, bool OUT32>
__device__ __forceinline__ void ln_phase(LAS unsigned char* lds, const float* x32, const bf16* Y, const float* ROUTE_in, const int* ROWS_in, const float* gam, const float* bet,
                                         float* outf, bf16* HBp, bf16* HBo, unsigned char* HB8p, const float* wr, float* ROUTE_out, unsigned* cnt, int gw, int NGW, const int wave) {
    FRESH_TID();
    LAS float* WR = (LAS float*)lds;
    LAS int* EL = (LAS int*)(lds + 32768);
    if (ROUTER) {
        for (int k = tid; k < DM; k += NWAVES * 64) { const f32x4 a = *(const f32x4*)(wr + k * 8), b = *(const f32x4*)(wr + k * 8 + 4);
            WR[0 * DM + k] = a[0]; WR[1 * DM + k] = a[1]; WR[2 * DM + k] = a[2]; WR[3 * DM + k] = a[3]; WR[4 * DM + k] = b[0]; WR[5 * DM + k] = b[1]; WR[6 * DM + k] = b[2]; WR[7 * DM + k] = b[3]; }
        for (int i = tid; i < 16 * ((T + NGW - 1) / NGW); i += NWAVES * 64) EL[i] = -1;
        LDS_WAIT(); __syncthreads();
    }
    int rk = 0;
    const int bxl = gw >> 3; const bool xm = (NGW == 2048);
    const int m0 = xm ? ((bxl & 7) << 12) + ((bxl >> 3) << 3) + wave : gw, mstr = xm ? 256 : NGW, mend = xm ? ((bxl & 7) << 12) + 4096 : T;
    f32x4 gv[4], bv[4];
#pragma unroll
    for (int j = 0; j < 4; ++j) { gv[j] = *(const f32x4*)(gam + 4 * lane + 256 * j); bv[j] = *(const f32x4*)(bet + 4 * lane + 256 * j); }
    v2u hq[4], yq[4]; f32x4 xq[4]; int r1q = 0, r2q = 0; float w1q = 0.f, w2q = 0.f;
    if (m0 < mend) { const unsigned ro = (unsigned)m0 * DM + 4 * lane;
#pragma unroll
        for (int j = 0; j < 4; ++j) { if (RES32) xq[j] = *(const f32x4*)(x32 + ro + 256 * j); else hq[j] = *(const v2u*)(HBp + ro + 256 * j); if (MODE == 0) yq[j] = *(const v2u*)(Y + ro + 256 * j); }
        if (MODE == 1) { r1q = ROWS_in[2 * m0]; r2q = ROWS_in[2 * m0 + 1]; w1q = ROUTE_in[(size_t)m0 * 8 + 4]; w2q = ROUTE_in[(size_t)m0 * 8 + 5]; } }
    for (int m = m0; m < mend; m += mstr) {
        f32x4 v[4]; float s = 0.f;
        const unsigned ro4 = (unsigned)m * DM + 4 * lane;
        f32x4 h[4];
        v2u yc[4]; const int r1 = r1q, r2 = r2q; const float w1 = w1q, w2 = w2q;
#pragma unroll
        for (int j = 0; j < 4; ++j) { if (RES32) h[j] = xq[j]; else { const v2u hw = hq[j]; h[j] = (f32x4){bf_lo(hw.x), bf_hi(hw.x), bf_lo(hw.y), bf_hi(hw.y)}; } yc[j] = yq[j]; }
        const bf16* y1 = Y + (size_t)r1 * DM + 4 * lane; const bf16* y2 = Y + (size_t)r2 * DM + 4 * lane;
        v2u ya[4], yb[4];
        if (MODE == 1) {
#pragma unroll
            for (int j = 0; j < 4; ++j) { ya[j] = *(const v2u*)(y1 + 256 * j); yb[j] = *(const v2u*)(y2 + 256 * j); } }
        if (m + mstr < mend) { const int mn = m + mstr; const unsigned ro = (unsigned)mn * DM + 4 * lane;
#pragma unroll
            for (int j = 0; j < 4; ++j) { if (RES32) xq[j] = *(const f32x4*)(x32 + ro + 256 * j); else hq[j] = *(const v2u*)(HBp + ro + 256 * j); if (MODE == 0) yq[j] = *(const v2u*)(Y + ro + 256 * j); }
            if (MODE == 1) { r1q = ROWS_in[2 * mn]; r2q = ROWS_in[2 * mn + 1]; w1q = ROUTE_in[(size_t)mn * 8 + 4]; w2q = ROUTE_in[(size_t)mn * 8 + 5]; } }
        if (MODE == 0) {
#pragma unroll
            for (int j = 0; j < 4; ++j) { const v2u y = yc[j];
                v[j][0] = DN_ALPHA * h[j][0] + bf_lo(y.x); v[j][1] = DN_ALPHA * h[j][1] + bf_hi(y.x); v[j][2] = DN_ALPHA * h[j][2] + bf_lo(y.y); v[j][3] = DN_ALPHA * h[j][3] + bf_hi(y.y); }
        } else {
#pragma unroll
            for (int j = 0; j < 4; ++j) { const v2u a = ya[j], b = yb[j];
                v[j][0] = DN_ALPHA * h[j][0] + (w1 * bf_lo(a.x) + w2 * bf_lo(b.x)); v[j][1] = DN_ALPHA * h[j][1] + (w1 * bf_hi(a.x) + w2 * bf_hi(b.x));
                v[j][2] = DN_ALPHA * h[j][2] + (w1 * bf_lo(a.y) + w2 * bf_lo(b.y)); v[j][3] = DN_ALPHA * h[j][3] + (w1 * bf_hi(a.y) + w2 * bf_hi(b.y)); }
        }
#pragma unroll
        for (int j = 0; j < 4; ++j) s += (v[j][0] + v[j][1]) + (v[j][2] + v[j][3]);
        const float mean = wave_sum(s) * (1.f / DM); float s2 = 0.f;
#pragma unroll
        for (int j = 0; j < 4; ++j) { v[j] = v[j] - mean; s2 += (v[j][0] * v[j][0] + v[j][1] * v[j][1]) + (v[j][2] * v[j][2] + v[j][3] * v[j][3]); }
        const float rstd = 1.f / __builtin_sqrtf(wave_sum(s2) * (1.f / DM) + LN_EPS);
#pragma unroll
        for (int j = 0; j < 4; ++j) { v[j] = v[j] * rstd * gv[j] + bv[j];
            if (OUT32) *(f32x4*)(outf + ro4 + 256 * j) = v[j];
            else if (HBo) { v2u w; w.x = cvt_pk_bf16(v[j][0], v[j][1]); w.y = cvt_pk_bf16(v[j][2], v[j][3]); *(v2u*)(HBo + ro4 + 256 * j) = w;
                if (HB8p) *(unsigned*)(HB8p + ro4 + 256 * j) = pack4_i8(v[j][0], v[j][1], v[j][2], v[j][3], QS_A); } }
        if (ROUTER) {
            float lg[8];
#pragma unroll
            for (int e = 0; e < 8; ++e) { float a = 0.f;
#pragma unroll
                for (int j = 0; j < 4; ++j) { const f32x4 w = *(const LAS f32x4*)(WR + e * DM + 4 * lane + 256 * j); a += (v[j][0] * w[0] + v[j][1] * w[1]) + (v[j][2] * w[2] + v[j][3] * w[3]); }
                lg[e] = wave_sum(a); }
            float b1 = lg[0]; int e1 = 0;
#pragma unroll
            for (int e = 1; e < 8; ++e) if (lg[e] > b1) { b1 = lg[e]; e1 = e; }
            float b2 = -3.0e38f; int e2 = 0;
#pragma unroll
            for (int e = 0; e < 8; ++e) if (e != e1 && lg[e] > b2) { b2 = lg[e]; e2 = e; }
            const float w1 = 1.f / (1.f + __expf(b2 - b1)), w2 = 1.f - w1;
            if (lane == 0) {
                const int q = rk * 8 + wave; EL[2 * q] = e1; EL[2 * q + 1] = e2;
                float* ro = ROUTE_out + (size_t)m * 8;
                ro[0] = __int_as_float(e1); ro[1] = __int_as_float(e2); ro[4] = w1; ro[5] = w2;
            }
            ++rk;
        }
    }
    if (ROUTER) {
        LDS_WAIT(); __syncthreads();
        if (wave == 0) {
            const int nent = 16 * ((T + NGW - 1) / NGW); const unsigned long long lt = (1ull << lane) - 1ull;
            int cntv = 0;
            for (int base = 0; base < nent; base += 64) { const int en = EL[base + lane];
#pragma unroll
                for (int e = 0; e < 8; ++e) { const unsigned long long bm = __ballot(en == e); if (lane == e) cntv += __builtin_popcountll(bm); } }
            int runv = 0; if (lane < 8) runv = (int)__hip_atomic_fetch_add(cnt + lane * 64, (unsigned)cntv, RLX_AGENT);
            for (int base = 0; base < nent; base += 64) { const int en = EL[base + lane]; int myrank = 0;
#pragma unroll
                for (int e = 0; e < 8; ++e) { const unsigned long long bm = __ballot(en == e); const int off = __shfl(runv, e); if (en == e) myrank = off + __builtin_popcountll(bm & lt); if (lane == e) runv += __builtin_popcountll(bm); }
                if (en >= 0) { const int idx = base + lane, q = idx >> 1, k2 = idx & 1; const int mrow = (m0 - wave) + (q & 7) + (q >> 3) * mstr; ROUTE_out[(size_t)mrow * 8 + 2 + k2] = __int_as_float(myrank); } }
        }
    }
}

__global__ void __launch_bounds__(NWAVES * 64, 2) mega_fwd(Args A0) {
    extern __shared__ __attribute__((aligned(16))) unsigned char lds_raw[];
    LAS unsigned char* const lds = (LAS unsigned char*)lds_raw;
    volatile LAS unsigned* const MISC = (volatile LAS unsigned*)(lds + MISC_OFF);
    const int tid0 = threadIdx.x, wave = __builtin_amdgcn_readfirstlane(tid0 >> 6);
    const int G = gridDim.x, NGW = G * NWAVES; int bx = blockIdx.x;
    int gw = bx * NWAVES + wave;
    for (int u = tid0; u < (LDS_BYTES - LDSCTL_OFF) / 4; u += NWAVES * 64) ((LAS unsigned*)(lds + LDSCTL_OFF))[u] = 0u;
    __syncthreads();
    XcdBarrier bar = xcd_barrier_post((unsigned*)(A0.ws + WS_CTL) + CW_BAR, MISC + 8);
#define GRID_BAR() xcd_barrier(bar)
    bool xl = false;
#if defined(MOE_W_LATE) && !defined(MOE1_IN_PROLOGUE)
    const bool skew1 = (G == 256);
#else
    const bool skew1 = false;
#endif
    const int PRO_MATS_ = skew1 ? MOE_PRO_MATS - 8 : MOE_PRO_MATS;
#define W1_CONVERT(gw_, ngw_, g0, g1, d0, d1) do { FRESH_TID(); \
        transpose_family_i8((A0.moe_w_gu + zl), (size_t)DM * 2 * MFF, 8, DM, 2 * MFF, 2 * MFF, (unsigned char*)(WSL + MW_GU), (size_t)2 * MFF * DM, MFF, QS_W32, nullptr, gw_, ngw_, lane, 0, g0, g1); \
        transpose_family_f8((A0.moe_w_down + zl), (size_t)MFF * DM, 8, MFF, DM, DM, (unsigned char*)(WSL + MW_DN), (size_t)DM * MFF, 0, 128.0f, nullptr, gw_, ngw_, lane, 0, d0, d1); } while (0)
#define LOCAL_BAR() do { if (xl) xcd_barrier_local(bar); else xcd_barrier(bar); } while (0)
#ifdef TIMING
    unsigned long long tprev = __builtin_amdgcn_s_memrealtime(); unsigned tc0 = 0, tc1 = 0, tc2 = 0, tc3 = 0, tc4 = 0, tc5 = 0, tc6 = 0, tc7 = 0;
#define TS(c) do { const unsigned long long tn_ = __builtin_amdgcn_s_memrealtime(); tc##c += (unsigned)(tn_ - tprev); tprev = tn_; } while (0)
#else
#define TS(c) do {} while (0)
#endif
#define C8SP ((float*)(WSL + WS_C8SP))
#define CBIAS ((float*)(WSL + WS_CBIAS))
#define ROUTE ((float*)(WSL + WS_ROUTE))
#define ROWS ((int*)(WSL + WS_ROWS))
#define SA ((float*)(WSL + WS_SA))
#define SH ((float*)(WSL + WS_SH))
#define CI ((float*)(WSL + WS_CI))
#define KCMP ((bf16*)(WSL + WS_KCMP))
#define CH ((bf16*)(WSL + WS_CH))
#define GT ((float*)(WSL + WS_GT))
#define HF ((float*)(WSL + WS_HF))
#define Y ((bf16*)(WSL + WS_Y))
#define HB ((bf16*)(WSL + WS_HB))
#define GATE ((bf16*)(WSL + WS_GATE))
#define UX ((bf16*)(WSL + WS_UX))
#define XR ((bf16*)(WSL + WS_XR))
#define AF ((float*)(WSL + WS_AF))
#define BF ((float*)(WSL + WS_BF))
#define HG ((bf16*)(WSL + WS_HG))
#define ACT ((bf16*)(WSL + WS_ACT))
#define AS ((bf16*)(WSL + WS_AS))
#define HS ((bf16*)(WSL + WS_HS))
#define YM ((bf16*)(WSL + WS_YM))
#define Qb ((bf16*)(WSL + WS_Q))
#define QRb ((bf16*)(WSL + WS_QR))
#define Ob ((bf16*)(WSL + WS_O))
#define KVT ((bf16*)(WSL + WS_KVT))
#define HB8 ((unsigned char*)(WSL + WS_HB8))
#define LN2_HB8 HB8
#define SCQ (1.0f / (QS_A * QS_W32))
#define CNTW(la) ((unsigned*)(WSL + WS_CTL) + CW_CNT + (la) * 8 * 64)
#define PHASE() size_t zl = 0; asm volatile("" : "+s"(zl)); unsigned char* const WSL = A0.ws + zl; (void)WSL

    for (int rep_ = 0; rep_ < REP0; ++rep_) { {
        PHASE(); FRESH_TID();
        LAS float* scr = (LAS float*)(lds + wave * 16384);
#ifdef PRO_PROBE
        const int PM_ = (rep_ < REP0 - 1) ? PRO_PROBE : 0;
#else
        const int PM_ = 0;
#endif
        for (int it = bx; it < 256; it += G) { const int jn = it >> 5, ks = it & 31, j = jn >> 2, n = (jn & 3) * 64 + (tid & 63), kq = tid >> 6; float a = 0.f;
            const float* pe = (A0.nsa_cmp_pos + zl) + j * 2048 + ks * 64 + kq * 8; const float* w1 = (A0.nsa_cmp_w1 + zl) + ((size_t)j * 2048 + ks * 64 + kq * 8) * 256 + n;
#pragma unroll
            for (int k = 0; k < 8; ++k) a += pe[k] * w1[(size_t)k * 256];
            LAS float* red = (LAS float*)(lds + 12288); red[kq * 64 + (tid & 63)] = a; LDS_WAIT(); __syncthreads();
            if (tid < 64) { float sm = 0.f;
#pragma unroll
                for (int q = 0; q < 8; ++q) sm += red[q * 64 + tid]; ((float*)(WSL + WS_CPART))[ks * 512 + j * 256 + (jn & 3) * 64 + tid] = sm; }
            __syncthreads(); }
        transpose_family_i8<true>((A0.moe_w_gu + zl), (size_t)DM * 2 * MFF, PRO_MATS_, DM, 2 * MFF, 2 * MFF, (unsigned char*)(WSL + MW_GU), (size_t)2 * MFF * DM, MFF, QS_W32, scr, gw, NGW, lane, PM_);
        transpose_family_f8<true>((A0.moe_w_down + zl), (size_t)MFF * DM, PRO_MATS_, MFF, DM, DM, (unsigned char*)(WSL + MW_DN), (size_t)DM * MFF, 0, 128.0f, scr, gw, NGW, lane, PM_);
        transpose_family_i8((A0.ffn_w_gu + zl), (size_t)DM * 2 * DFF, 2, DM, 2 * DFF, 2 * DFF, (unsigned char*)(WSL + W_GU), (size_t)2 * DFF * DM, DFF, QS_W32, scr, gw, NGW, lane);
#ifdef FFN_DN_F8
        transpose_family_f8((A0.ffn_w_down + zl), (size_t)DFF * DM, 2, DFF, DM, DM, (unsigned char*)(WSL + W_DN), (size_t)DM * DFF, 0, 128.0f, scr, gw, NGW, lane);
#else
        transpose_family((A0.ffn_w_down + zl), (size_t)DFF * DM, 2, DFF, DM, DM, (bf16*)(WSL + W_DN), (size_t)DM * DFF, 0, scr, gw, NGW, lane);
#endif
        transpose_family_i8((A0.lru_w_in + zl), (size_t)DM * 2048, 2, DM, 2048, 2048, (unsigned char*)(WSL + W_IN), (size_t)2048 * DM, 0, QS_W32, scr, gw, NGW, lane);
#ifdef OUTPROJ_F8
        transpose_family_f8((A0.lru_w_out + zl), (size_t)DM * DM, 2, DM, DM, DM, (unsigned char*)(WSL + W_OUT), (size_t)DM * DM, 0, 64.0f, scr, gw, NGW, lane);
#else
        transpose_family((A0.lru_w_out + zl), (size_t)DM * DM, 2, DM, DM, DM, (bf16*)(WSL + W_OUT), (size_t)DM * DM, 0, scr, gw, NGW, lane);
#endif
        transpose_family_i8((A0.nsa_w_kv + zl), 0, 1, DM, NKVP, NKVP, (unsigned char*)(WSL + W_KV), 0, 0, QS_W32, scr, gw, NGW, lane);
        transpose_family((A0.nsa_cmp_w1 + zl), (size_t)2048 * 256, 2, 2048, 256, 256, (bf16*)(WSL + W_C1), (size_t)256 * 2048, 0, scr, gw, NGW, lane);
        transpose_family_i8((A0.nsa_w_qg + zl), (size_t)DM * NQG, 2, DM, NQG, NQG_PAD, (unsigned char*)(WSL + W_QG), (size_t)NQG_PAD * DM, 0, QS_W32, scr, gw, NGW, lane);
        transpose_family_f8((A0.nsa_w_o + zl), (size_t)DM * DM, 2, DM, DM, DM, (unsigned char*)(WSL + W_O), (size_t)DM * DM, 0, 64.0f, scr, gw, NGW, lane);
        transpose_family((A0.lru_w_a + zl), (size_t)128 * 128, 16, 128, 128, 128, (bf16*)(WSL + W_GATE), (size_t)256 * 128, 0, scr, gw, NGW, lane);
        transpose_family((A0.lru_w_i + zl), (size_t)128 * 128, 16, 128, 128, 128, (bf16*)(WSL + W_GATE) + 128 * 128, (size_t)256 * 128, 0, scr, gw, NGW, lane);
        { const float* xin = (A0.x + zl); for (size_t i = (size_t)(bx * 512 + tid); i < (size_t)T * DM / 8; i += (size_t)G * 512) { const f32x4 a = *(const f32x4*)(xin + i * 8), b = *(const f32x4*)(xin + i * 8 + 4); *(v4u*)(HB + i * 8) = pack8(a, b);
            *(v2u*)(HB8 + i * 8) = (v2u){pack4_i8(a[0], a[1], a[2], a[3], QS_A), pack4_i8(b[0], b[1], b[2], b[3], QS_A)};
        } }
        for (int i = bx * 512 + tid; i < 2 * DM; i += G * 512) { const float lam = (A0.lru_lambda + zl)[i]; C8SP[i] = 8.0f * log1pf(__expf(-lam)); }
    }
            GRID_BAR(); } TS(0);
    if (G == 256 && __builtin_amdgcn_readfirstlane((int)MISC[10]) != 0) { xl = true; bx = (int)bar.x + 8 * __builtin_amdgcn_readfirstlane((int)MISC[11]); gw = bx * NWAVES + wave; }
    if (skew1) { PHASE();
        const int gwg_ = ((((bx & 7) >> 1) << 5) + (bx >> 3)) * NWAVES + wave;
        if (!xl) W1_CONVERT(gw, NGW, 0, 0x7fffffff, 0, 0x7fffffff);
        else if (bx & 1) W1_CONVERT(gwg_, 1024, 0, 14, 0, 7);
    }

#ifndef NLAYERS
#define NLAYERS 4
#endif
    for (int l = 0; l < NLAYERS; ++l) {
        const int la = l & 1;
        const int lf = l >> 1;
        if (l < 2) {
            for (int rep_ = 0; rep_ < REP1; ++rep_) { {
                PHASE();
                pg8::Gemm g{(const bf16*)HB8, (const bf16*)(WSL + W_IN + (size_t)la * 2048 * DM), DM / 2, DM / 2, DM / 2};
                pg8::DenseOrder S; S.init(T / 256, 8, G, bx, (size_t)256 * DM, 0, (size_t)256 * DM);
                EpiInProj E{GATE, UX, SCQ};
                pg8::gemm_phase<EpiInProj, pg8::DenseOrder, true, true, 2>(lds, g, S, E, wave);
            }
            LOCAL_BAR(); } TS(1);
            for (int rep_ = 0; rep_ < REP5; ++rep_) { {
                PHASE(); FRESH_TID();
                if (l == 0 && bx == 0) { const float* cp = (const float*)(WSL + WS_CPART); float cq[32];
#pragma unroll
                    for (int q = 0; q < 32; ++q) cq[q] = cp[q * 512 + tid];
                    float sm = 0.f;
#pragma unroll
                    for (int q = 0; q < 32; ++q) sm += cq[q];
                    CBIAS[tid] = sm; }
                const float* cw = (A0.lru_conv_w + zl) + (size_t)la * 4 * DM; const float* cb = (A0.lru_conv_b + zl) + (size_t)la * DM;
                const bf16* ux = UX; bf16* xr = XR;
                for (int it0 = bx * 512 + tid; it0 < (T / 16) * 128; it0 += G * 512) {
                    const int it = (G == 256) ? ((bx & 7) << 15) + ((bx >> 3) << 10) + tid + ((it0 >> 17) << 9) : it0;
                    const int rb = it >> 7, cg = it & 127, r0 = rb * 16, s0 = r0 & 2047, ch = cg * 8;
                    float wt[4][8], bb[8];
#pragma unroll
                    for (int k = 0; k < 4; ++k) { const f32x4 w0 = *(const f32x4*)(cw + k * DM + ch), w1 = *(const f32x4*)(cw + k * DM + ch + 4);
                        wt[k][0] = w0[0]; wt[k][1] = w0[1]; wt[k][2] = w0[2]; wt[k][3] = w0[3]; wt[k][4] = w1[0]; wt[k][5] = w1[1]; wt[k][6] = w1[2]; wt[k][7] = w1[3]; }
                    { const f32x4 b0 = *(const f32x4*)(cb + ch), b1 = *(const f32x4*)(cb + ch + 4); bb[0] = b0[0]; bb[1] = b0[1]; bb[2] = b0[2]; bb[3] = b0[3]; bb[4] = b1[0]; bb[5] = b1[1]; bb[6] = b1[2]; bb[7] = b1[3]; }
                    v4u u0 = (v4u){0u, 0u, 0u, 0u}, u1 = u0, u2 = u0;
                    if (s0 != 0) { u0 = *(const v4u*)(ux + (size_t)(r0 - 3) * DM + ch); u1 = *(const v4u*)(ux + (size_t)(r0 - 2) * DM + ch); u2 = *(const v4u*)(ux + (size_t)(r0 - 1) * DM + ch); }
                    v4u un[16];
#pragma unroll
                    for (int j = 0; j < 16; ++j) un[j] = *(const v4u*)(ux + (size_t)(r0 + j) * DM + ch);
#pragma unroll
                    for (int j = 0; j < 16; ++j) { const v4u u3 = un[j];
                        const unsigned w0[4] = {u0.x, u0.y, u0.z, u0.w}, w1[4] = {u1.x, u1.y, u1.z, u1.w}, w2[4] = {u2.x, u2.y, u2.z, u2.w}, w3[4] = {u3.x, u3.y, u3.z, u3.w};
                        float a[8];
#pragma unroll
                        for (int q = 0; q < 4; ++q) {
                            a[2 * q] = bb[2 * q] + wt[0][2 * q] * bf_lo(w0[q]) + wt[1][2 * q] * bf_lo(w1[q]) + wt[2][2 * q] * bf_lo(w2[q]) + wt[3][2 * q] * bf_lo(w3[q]);
                            a[2 * q + 1] = bb[2 * q + 1] + wt[0][2 * q + 1] * bf_hi(w0[q]) + wt[1][2 * q + 1] * bf_hi(w1[q]) + wt[2][2 * q + 1] * bf_hi(w2[q]) + wt[3][2 * q + 1] * bf_hi(w3[q]); }
                        v4u o; o.x = cvt_pk_bf16(a[0], a[1]); o.y = cvt_pk_bf16(a[2], a[3]); o.z = cvt_pk_bf16(a[4], a[5]); o.w = cvt_pk_bf16(a[6], a[7]);
                        *(v4u*)(xr + (size_t)(r0 + j) * DM + ch) = o;
                        u0 = u1; u1 = u2; u2 = u3; } }
            }
            LOCAL_BAR(); } TS(5);
            for (int rep_ = 0; rep_ < REP1; ++rep_) { {
                PHASE();
                pg8::Gemm g{XR, (const bf16*)(WSL + W_GATE) + (size_t)la * 2048 * 128, DM, 128, 128};
                pg8::DenseOrder S; S.init(T / 256, 8, G, bx, (size_t)256 * DM * 2, (size_t)128 * 2, (size_t)256 * 128 * 2);
#ifdef GATES_PROBE
                EpiGates E{XR, (A0.lru_b_a + zl) + la * DM, (A0.lru_b_i + zl) + la * DM, C8SP + la * DM, (bf16*)AF, (bf16*)BF, (rep_ < REP1 - 1) ? GATES_PROBE : 0};
#else
                EpiGates E{XR, (A0.lru_b_a + zl) + la * DM, (A0.lru_b_i + zl) + la * DM, C8SP + la * DM, (bf16*)AF, (bf16*)BF, 0};
#endif
#if !defined(NO_G2)
                pg8::gemm_phase<EpiGates, pg8::DenseOrder, true, true>(lds, g, S, E, wave);
#endif
            }
            LOCAL_BAR(); } TS(1);
            for (int rep_ = 0; rep_ < REP5; ++rep_) { {   PHASE(); FRESH_TID();
                const unsigned* af = (const unsigned*)AF; const unsigned* bf = (const unsigned*)BF; f32x2* sa = (f32x2*)SA; f32x2* sh = (f32x2*)SH;
                const float nsp0 = -C8SP[la * DM + 2 * tid] * (1.0f / 65535.0f), nsp1 = -C8SP[la * DM + 2 * tid + 1] * (1.0f / 65535.0f);
                for (int it0 = bx; it0 < BATCH * 32; it0 += G) { const int it = (G == 256) ? ((bx & 7) << 6) + (bx >> 3) + ((it0 >> 8) << 5) : it0, b = it >> 5, c = it & 31;     const unsigned r0 = ((unsigned)(b * SEQ + c * 64) * DM) / 2 + tid;
                    float A0_ = 1.f, A1_ = 1.f, H0 = 0.f, H1 = 0.f;
                    unsigned la[2][16], bt[2][16];
#pragma unroll
                    for (int s = 0; s < 16; ++s) { la[0][s] = af[r0 + (unsigned)s * (DM / 2)]; bt[0][s] = bf[r0 + (unsigned)s * (DM / 2)]; }
#pragma unroll
                    for (int hb = 0; hb < 4; ++hb) {
                        if (hb < 3) {
#pragma unroll
                            for (int s = 0; s < 16; ++s) { la[(hb + 1) & 1][s] = af[r0 + (unsigned)((hb + 1) * 16 + s) * (DM / 2)]; bt[(hb + 1) & 1][s] = bf[r0 + (unsigned)((hb + 1) * 16 + s) * (DM / 2)]; } }
#pragma unroll
                        for (int s = 0; s < 16; ++s) { const unsigned lw = la[hb & 1][s], bw = bt[hb & 1][s];
                            const float a0 = fast_exp((float)(lw & 0xffffu) * nsp0), a1 = fast_exp((float)(lw >> 16) * nsp1); H0 = a0 * H0 + bf_lo(bw); H1 = a1 * H1 + bf_hi(bw); A0_ *= a0; A1_ *= a1; } }
                    sa[(unsigned)(b * 32 + c) * (DM / 2) + tid] = (f32x2){A0_, A1_}; sh[(unsigned)(b * 32 + c) * (DM / 2) + tid] = (f32x2){H0, H1}; } }
            LOCAL_BAR(); } TS(5);
            for (int rep_ = 0; rep_ < REP5; ++rep_) { {   PHASE(); FRESH_TID();
                const unsigned* af = (const unsigned*)AF; const unsigned* bf = (const unsigned*)BF; const f32x2* sa = (const f32x2*)SA; const f32x2* sh = (const f32x2*)SH; const unsigned* gate = (const unsigned*)GATE; unsigned* hg = (unsigned*)HG;
                const float nsp0 = -C8SP[la * DM + 2 * tid] * (1.0f / 65535.0f), nsp1 = -C8SP[la * DM + 2 * tid + 1] * (1.0f / 65535.0f);
                for (int it0 = bx; it0 < BATCH * 32; it0 += G) { const int it = (G == 256) ? ((bx & 7) << 6) + (bx >> 3) + ((it0 >> 8) << 5) : it0, b = it >> 5, c = it & 31;     const unsigned r0 = ((unsigned)(b * SEQ + c * 64) * DM) / 2 + tid;
                    float H0 = 0.f, H1 = 0.f;
                    { f32x2 A2[31], S2[31];
#pragma unroll
                      for (int c2 = 0; c2 < 31; ++c2) { const unsigned o = (unsigned)(b * 32 + (c2 < c ? c2 : 0)) * (DM / 2) + tid; A2[c2] = sa[o]; S2[c2] = sh[o]; }
#pragma unroll
                      for (int c2 = 0; c2 < 31; ++c2) if (c2 < c) { H0 = A2[c2][0] * H0 + S2[c2][0]; H1 = A2[c2][1] * H1 + S2[c2][1]; } }
                    unsigned la[2][16], bt[2][16], gg[2][16];
#pragma unroll
                    for (int s = 0; s < 16; ++s) { const unsigned o = r0 + (unsigned)s * (DM / 2); la[0][s] = af[o]; bt[0][s] = bf[o]; gg[0][s] = gate[o]; }
#pragma unroll
                    for (int hb = 0; hb < 4; ++hb) {
                        if (hb < 3) {
#pragma unroll
                            for (int s = 0; s < 16; ++s) { const unsigned o = r0 + (unsigned)((hb + 1) * 16 + s) * (DM / 2); la[(hb + 1) & 1][s] = af[o]; bt[(hb + 1) & 1][s] = bf[o]; gg[(hb + 1) & 1][s] = gate[o]; } }
#pragma unroll
                        for (int s = 0; s < 16; ++s) { const unsigned lw = la[hb & 1][s], bw = bt[hb & 1][s], gw_ = gg[hb & 1][s];
                            const float a0 = fast_exp((float)(lw & 0xffffu) * nsp0), a1 = fast_exp((float)(lw >> 16) * nsp1); H0 = a0 * H0 + bf_lo(bw); H1 = a1 * H1 + bf_hi(bw);
#ifdef OUTPROJ_F8
                            ((unsigned short*)hg)[r0 + (unsigned)(hb * 16 + s) * (DM / 2)] = (unsigned short)__builtin_amdgcn_cvt_pk_fp8_f32(H0 * bf_lo(gw_), H1 * bf_hi(gw_), 0, false); } } } }
#else
                            hg[r0 + (unsigned)(hb * 16 + s) * (DM / 2)] = cvt_pk_bf16(H0 * bf_lo(gw_), H1 * bf_hi(gw_)); } } } }
#endif
            LOCAL_BAR(); } TS(5);
            for (int rep_ = 0; rep_ < REP1; ++rep_) { {
                PHASE();
#ifdef OUTPROJ_F8
                pg8::Gemm g{HG, (const bf16*)(WSL + W_OUT + (size_t)la * DM * DM), DM / 2, DM / 2, DM / 2};
                pg8::DenseOrder S; S.init(T / 256, 4, G, bx, (size_t)256 * DM, 0, (size_t)256 * DM);
                EpiStore E{Y, DM, 1.0f / 64.0f};
                pg8::gemm_phase<EpiStore, pg8::DenseOrder, true, true, 1>(lds, g, S, E, wave);
#else
                pg8::Gemm g{HG, (const bf16*)(WSL + W_OUT) + (size_t)la * DM * DM, DM, DM, DM};
                pg8::DenseOrder S; S.init(T / 256, 4, G, bx, (size_t)256 * DM * 2, 0, (size_t)256 * DM * 2);
                EpiStore E{Y, DM, 1.0f};
                pg8::gemm_phase<EpiStore, pg8::DenseOrder, true, true>(lds, g, S, E, wave);
#endif
            }
            LOCAL_BAR(); } TS(1);
        } else {
            if (l != 2) for (int rep_ = 0; rep_ < REP1; ++rep_) { {
                PHASE();
                pg8::Gemm g{(const bf16*)HB8, (const bf16*)(WSL + W_QG + (size_t)la * NQG_PAD * DM), DM / 2, DM / 2, DM / 2};
                pg8::DenseOrder S; S.init(T / 256, 5, G, bx, (size_t)256 * DM, 0, (size_t)256 * DM);
                EpiQG E{Qb, QRb, GT, SCQ};
#if !defined(NO_G4)
                pg8::gemm_phase<EpiQG, pg8::DenseOrder, true, true, 2>(lds, g, S, E, wave);
#endif
            }
            LOCAL_BAR(); } TS(1);
#ifdef ZERO_ATTN
            {   PHASE(); FRESH_TID(); bf16* o = Ob; for (size_t i = (size_t)(bx * 512 + tid); i < (size_t)T * DM / 8; i += (size_t)G * 512) *(v4u*)(o + i * 8) = (v4u){0u, 0u, 0u, 0u}; }
#elif !defined(NO_ATTN)
            for (int rep_ = 0; rep_ < REP4; ++rep_) {   PHASE(); if (rep_) GRID_BAR();
                for (int L = bx; L < BATCH * NKV * 32; L += G) { int bg = L & 63, qt = ((L >> 6) + 5 * bg) & 31;
                    if (G == 256) {
                        const int r_ = bx >> 3, ui = (L - bx) >> 8, a_ = ((r_ >> 3) + r_) & 3;
                        bg = ((((bx & 7) << 1) + (r_ & 1)) << 2) + ((r_ >> 1) & 3); qt = 4 * ui + ((ui & 1) ? 3 - a_ : a_); }
#ifdef ATT_PROBE
                    if (rep_ == 0) nsa::attn_unit<ATT_PROBE>(lds, bg >> 2, bg & 3, qt, Qb, QRb, GT, KVT, KCMP, (bf16*)(WSL + WS_HF + 64 * MiB), (float*)(WSL + WS_CTL) + 2048, wave); else
#endif
                    nsa::attn_unit<0>(lds, bg >> 2, bg & 3, qt, Qb, QRb, GT, KVT, KCMP, Ob, (float*)(WSL + WS_CTL) + 2048, wave);
#ifdef MOE_W_LATE
                    {
                        const int ui_ = (L - bx) / G;
                        const int nu_ = (BATCH * NKV * 32 + G - 1) / G;
                        const bool par_ = skew1 && xl;
                        const int sgw_ = par_ ? ((((bx & 7) >> 1) << 5) + (bx >> 3)) * NWAVES + wave : gw, sng_ = par_ ? 1024 : NGW;
                        const int ng_ = (8 * 16 * 224 + sng_ - 1) / sng_, nd_ = (8 * 56 * 32 + sng_ - 1) / sng_;
                        const int hg_ = par_ ? (ng_ + 1) / 2 : ng_, hd_ = par_ ? (nd_ + 1) / 2 : nd_;
                        const int rg_ = (hg_ + nu_ - 1) / nu_, rd_ = (hd_ + nu_ - 1) / nu_;
                        const bool mine_ = par_ ? ((l == 2) == ((bx & 1) != 0)) : (l == 2);
                        const int og_ = (par_ && l == 3) ? hg_ : 0, od_ = (par_ && l == 3) ? hd_ : 0, eg_ = og_ + hg_ < ng_ ? og_ + hg_ : ng_, ed_ = od_ + hd_ < nd_ ? od_ + hd_ : nd_;
                        if (mine_) { FRESH_TID();
                            const int g0_ = og_ + ui_ * rg_, g1_ = (g0_ + rg_ < eg_) ? g0_ + rg_ : eg_, d0_ = od_ + ui_ * rd_, d1_ = (d0_ + rd_ < ed_) ? d0_ + rd_ : ed_;
                            if (g0_ < g1_) transpose_family_i8((A0.moe_w_gu + zl) + (size_t)8 * DM * 2 * MFF, (size_t)DM * 2 * MFF, 8, DM, 2 * MFF, 2 * MFF, (unsigned char*)(WSL + MW_GU) + (size_t)8 * 2 * MFF * DM, (size_t)2 * MFF * DM, MFF, QS_W32, nullptr, sgw_, sng_, lane, 0, g0_, g1_);
                            if (d0_ < d1_) transpose_family_f8((A0.moe_w_down + zl) + (size_t)8 * MFF * DM, (size_t)MFF * DM, 8, MFF, DM, DM, (unsigned char*)(WSL + MW_DN) + (size_t)8 * DM * MFF, (size_t)DM * MFF, 0, 128.0f, nullptr, sgw_, sng_, lane, 0, d0_, d1_);
                        }
                    }
#endif
                } }
#endif
            LOCAL_BAR(); TS(4);
            for (int rep_ = 0; rep_ < REP1; ++rep_) { {
                PHASE();
                pg8::Gemm g{Ob, (const bf16*)(WSL + W_O + (size_t)la * DM * DM), DM / 2, DM / 2, DM / 2};
                pg8::DenseOrder S; S.init(T / 256, 4, G, bx, (size_t)256 * DM, 0, (size_t)256 * DM);
                EpiStore E{Y, DM, 1.0f / 64.0f};
#if !defined(NO_G5)
                pg8::gemm_phase<EpiStore, pg8::DenseOrder, true, true, true>(lds, g, S, E, wave);
#endif
            }
            LOCAL_BAR(); } TS(1);
        }
        for (int rep_ = REP6 - 1; rep_ >= 0; --rep_) { bf16* const HBO_ = rep_ ? LN_DUMMY_OUT : (bf16*)(A0.ws + WS_HB); {   PHASE();
            const float* g1 = (A0.ln_g + zl) + (size_t)(l * 2) * DM; const float* b1 = (A0.ln_b + zl) + (size_t)(l * 2) * DM;
            if (l == 0) ln_phase<0, false, true, false>(lds, A0.x + zl, Y, nullptr, nullptr, g1, b1, nullptr, HB, HBO_, HB8, nullptr, nullptr, nullptr, gw, NGW, wave);
            else if ((l & 1) == 0) ln_phase<0, false, false, false>(lds, nullptr, Y, nullptr, nullptr, g1, b1, nullptr, HB, HBO_, HB8, nullptr, nullptr, nullptr, gw, NGW, wave);
            else if (rep_) ln_phase<0, false, false, false>(lds, nullptr, Y, nullptr, nullptr, g1, b1, nullptr, HB, HBO_, nullptr, nullptr, nullptr, nullptr, gw, NGW, wave);
            else ln_phase<0, true, false, false>(lds, nullptr, Y, nullptr, nullptr, g1, b1, nullptr, HB, HBO_, HB8, (A0.moe_w_router + zl) + (size_t)lf * DM * 8, ROUTE, CNTW(lf), gw, NGW, wave);
        }
            if (skew1 && xl && l == 1 && !(bx & 1)) { PHASE(); const int gwg_ = ((((bx & 7) >> 1) << 5) + (bx >> 3)) * NWAVES + wave; W1_CONVERT(gwg_, 1024, 14, 28, 7, 14); }
            if ((l & 1) == 0) LOCAL_BAR(); else GRID_BAR();     } TS(6);
        if ((l & 1) == 0) {
            for (int rep_ = 0; rep_ < REP2; ++rep_) { {
                PHASE();
                pg8::Gemm g{(const bf16*)HB8, (const bf16*)(WSL + W_GU + (size_t)lf * 2 * DFF * DM), DM / 2, DM / 2, DM / 2};
                pg8::DenseOrder S; S.init(T / 256, 2 * DFF / 256, G, bx, (size_t)256 * DM, 0, (size_t)256 * DM);
#ifdef FFN_DN_F8
                EpiSwiglu8 E{(unsigned char*)ACT, DFF, SCQ};
                pg8::gemm_phase<EpiSwiglu8, pg8::DenseOrder, true, true, 2>(lds, g, S, E, wave);
#else
                EpiSwiglu E{ACT, DFF, SCQ};
                pg8::gemm_phase<EpiSwiglu, pg8::DenseOrder, true, true, 2>(lds, g, S, E, wave);
#endif
            }
            LOCAL_BAR(); } TS(2);
            for (int rep_ = 0; rep_ < REP2; ++rep_) { {
                PHASE();
#ifdef FFN_DN_F8
                pg8::Gemm g{ACT, (const bf16*)(WSL + W_DN + (size_t)lf * DM * DFF), DFF / 2, DFF / 2, DFF / 2};
                pg8::DenseOrder S; S.init(T / 256, 4, G, bx, (size_t)256 * DFF, 0, (size_t)256 * DFF);
                EpiStore E{Y, DM, 1.0f / 128.0f};
                pg8::gemm_phase<EpiStore, pg8::DenseOrder, true, true, 1>(lds, g, S, E, wave);
#else
                pg8::Gemm g{ACT, (const bf16*)(WSL + W_DN) + (size_t)lf * DM * DFF, DFF, DFF, DFF};
                pg8::DenseOrder S; S.init(T / 256, 4, G, bx, (size_t)256 * DFF * 2, 0, (size_t)256 * DFF * 2);
                EpiStore E{Y, DM, 1.0f};
                pg8::gemm_phase<EpiStore, pg8::DenseOrder, true, true>(lds, g, S, E, wave);
#endif
            }
            LOCAL_BAR(); } TS(2);
            for (int rep_ = REP6 - 1; rep_ >= 0; --rep_) { bf16* const HBO_ = rep_ ? LN_DUMMY_OUT : (bf16*)(A0.ws + WS_HB); {   PHASE();
                ln_phase<0, false, false, false>(lds, nullptr, Y, nullptr, nullptr, (A0.ln_g + zl) + (size_t)(l * 2 + 1) * DM, (A0.ln_b + zl) + (size_t)(l * 2 + 1) * DM, nullptr, HB, HBO_, LN2_HB8, nullptr, nullptr, nullptr, gw, NGW, wave);
            }
            LOCAL_BAR(); } TS(6);
        } else {
#define LOAD_TP() int tp[9]; tp[0] = 0; { unsigned* const cnt_ = CNTW(lf); const int ln_ = (int)__builtin_amdgcn_mbcnt_hi(~0u, __builtin_amdgcn_mbcnt_lo(~0u, 0u)); unsigned cv_ = 0u; if (ln_ < 8) cv_ = __hip_atomic_load(cnt_ + ln_ * 64, RLX_AGENT);   _Pragma("unroll") for (int e = 0; e < 8; ++e) { const unsigned c = (unsigned)__builtin_amdgcn_readlane((int)cv_, e); tp[e + 1] = tp[e] + (int)((c + 255u) >> 8); } }
            for (int rep_ = 0; rep_ < REP7; ++rep_) { {
                PHASE(); FRESH_TID(); LOAD_TP();
                LAS int* TB = (LAS int*)lds;
                if (tid < 8) { int v = 0;
#pragma unroll
                    for (int e = 0; e < 8; ++e) if (tid == e) v = tp[e]; TB[tid] = v * 256; }
                LDS_WAIT(); __syncthreads();
                const float* route = ROUTE; const unsigned char* hb8 = HB8; bf16* as = AS; int* rows = ROWS;
                for (int it = gw; it < 2 * T; it += 4 * NGW) { int ev[4], pv[4]; v4u dv[4];
#pragma unroll
                    for (int q = 0; q < 4; ++q) { const int i2 = (it + q * NGW < 2 * T) ? it + q * NGW : it, m = i2 >> 1, k = i2 & 1; const float* ro = route + (size_t)m * 8; ev[q] = __float_as_int(ro[k]); pv[q] = __float_as_int(ro[2 + k]);
                        dv[q] = *(const v4u*)(hb8 + (size_t)m * DM + lane * 16); }
#pragma unroll
                    for (int q = 0; q < 4; ++q) { const int i2 = it + q * NGW; const int row = TB[ev[q]] + pv[q];
                        if (i2 < 2 * T) { *(v4u*)((unsigned char*)as + (size_t)row * DM + lane * 16) = dv[q];
                            if (lane == 0) rows[i2] = row; } } }
            }
            GRID_BAR(); } TS(7);
            for (int rep_ = 0; rep_ < REP3; ++rep_) { {
                PHASE(); LOAD_TP();
                pg8::Gemm g{AS, (const bf16*)(WSL + MW_GU + (size_t)lf * 8 * 2 * MFF * DM), DM / 2, DM / 2, DM / 2};
                pg8::GroupOrder S{tp[1], tp[2], tp[3], tp[4], tp[5], tp[6], tp[7], tp[8], 2 * MFF / 256, tp[8] * (2 * MFF / 256), G, bx, (size_t)256 * DM, (size_t)256 * DM};
                EpiSwiglu8 E{(unsigned char*)HS, MFF, SCQ};
                if (xl && (bx & 1)) { for (int z_ = 0; z_ < 2; ++z_) __builtin_amdgcn_s_sleep(127); }
#if !defined(NO_G8)
                pg8::gemm_phase<EpiSwiglu8, pg8::GroupOrder, true, true, 2>(lds, g, S, E, wave);
#endif
            }
            GRID_BAR(); } TS(3);
            for (int rep_ = 0; rep_ < REP3; ++rep_) { {
                PHASE(); LOAD_TP();
                pg8::Gemm g{HS, (const bf16*)(WSL + MW_DN + (size_t)lf * 8 * DM * MFF), MFF / 2, MFF / 2, MFF / 2};
                pg8::GroupOrder S{tp[1], tp[2], tp[3], tp[4], tp[5], tp[6], tp[7], tp[8], 4, tp[8] * 4, G, bx, (size_t)256 * MFF, (size_t)256 * MFF};
                EpiStore E{YM, DM, 1.0f / 128.0f};
#if !defined(NO_G9)
                pg8::gemm_phase<EpiStore, pg8::GroupOrder, true, true, true>(lds, g, S, E, wave);
#endif
            }
            GRID_BAR(); } TS(3);
            for (int rep_ = REP6 - 1; rep_ >= 0; --rep_) { bf16* const HBO_ = rep_ ? LN_DUMMY_OUT : (bf16*)(A0.ws + WS_HB); {   PHASE();
                const float* g2 = (A0.ln_g + zl) + (size_t)(l * 2 + 1) * DM; const float* b2 = (A0.ln_b + zl) + (size_t)(l * 2 + 1) * DM;
                if (l == 3) ln_phase<1, false, false, true>(lds, nullptr, YM, ROUTE, ROWS, g2, b2, A0.out + zl, HB, HBO_, nullptr, nullptr, nullptr, nullptr, gw, NGW, wave);
                else ln_phase<1, false, false, false>(lds, nullptr, YM, ROUTE, ROWS, g2, b2, nullptr, HB, HBO_, LN2_HB8, nullptr, nullptr, nullptr, gw, NGW, wave);
            }
            if (l == 1) LOCAL_BAR();     } TS(6);
        }
        if (l == 1) {
            for (int rep_ = 0; rep_ < REP1; ++rep_) { {
                PHASE();
                pg8::Gemm g{(const bf16*)HB8, (const bf16*)(WSL + W_KV), DM / 2, DM / 2, DM / 2};
                pg8::DenseOrder S; S.init(T / 256, 6, G, bx, (size_t)256 * DM, 0, (size_t)256 * DM);
                EpiKV E{KVT, SCQ};
#if !defined(NO_G10)
                pg8::gemm_phase<EpiKV, pg8::DenseOrder, true, true, 2>(lds, g, S, E, wave);
#endif
            }
            LOCAL_BAR(); } TS(1);
            for (int rep_ = 0; rep_ < REP1; ++rep_) { {
                PHASE();
                const int nC = (G >= 128) ? 64 : G / 2;
                if (bx < nC) {
                    pg8::Gemm g{KVT, (const bf16*)(WSL + W_C1), 1024, 2048, 2048};
                    EpiCmp E{CH, CBIAS};
                    if (G == 256) {
                        pg8::OneUnit S{4 * (bx & 7) + ((bx >> 3) & 3), bx >> 5, (size_t)256 * 1024 * 2, (size_t)BATCH * NKV * SEQ * HD * 2, (size_t)256 * 2048 * 2};
                        pg8::gemm_phase<EpiCmp, pg8::OneUnit, true, true>(lds, g, S, E, wave);
                    } else {
                        pg8::DenseOrder S; S.init(32, 2, nC, bx, (size_t)256 * 1024 * 2, (size_t)BATCH * NKV * SEQ * HD * 2, (size_t)256 * 2048 * 2);
                        pg8::gemm_phase<EpiCmp, pg8::DenseOrder, true, true>(lds, g, S, E, wave);
                    }
                } else {
                    pg8::Gemm g{(const bf16*)HB8, (const bf16*)(WSL + W_QG), DM / 2, DM / 2, DM / 2};
                    pg8::DenseOrder S; S.init(T / 256, 5, G - nC, bx - nC, (size_t)256 * DM, 0, (size_t)256 * DM);
                    EpiQG E{Qb, QRb, GT, SCQ};
                    pg8::gemm_phase<EpiQG, pg8::DenseOrder, true, true, 2>(lds, g, S, E, wave);
                }
            }
            LOCAL_BAR(); } TS(1);
            for (int rep_ = 0; rep_ < REP7; ++rep_) { {
                PHASE(); FRESH_TID();
                LAS float* W2 = (LAS float*)lds;
                const float* w2g = (A0.nsa_cmp_w2 + zl); const bf16* chp = CH; bf16* kcmp = KCMP;
                for (int j = 0; j < 2; ++j) {
                    __syncthreads();
                    for (int i = tid; i < 256 * 64 / 4; i += 512) *(LAS f32x4*)(W2 + i * 4) = *(const f32x4*)(w2g + (size_t)j * 256 * 64 + i * 4);
                    LDS_WAIT(); __syncthreads();
                    const bool xmp = (G == 256); const int rb0 = xmp ? ((bx & 7) << 10) + ((bx >> 3) << 3) + wave : gw, rst = xmp ? 256 : NGW, rlim = xmp ? ((bx & 7) << 10) + 1024 : 8192;
                    for (int rowb = rb0; rowb < rlim; rowb += 4 * rst) { v2u hv[4]; float a[4] = {0.f, 0.f, 0.f, 0.f};
#pragma unroll
                        for (int q = 0; q < 4; ++q) { const int row = (rowb + q * rst < rlim) ? rowb + q * rst : rowb; hv[q] = *(const v2u*)(chp + ((size_t)j * 8192 + row) * 256 + lane * 4); }
#pragma unroll 8
                        for (int sl = 0; sl < 64; ++sl) { const LAS float* wp = W2 + (4 * sl) * 64 + lane; const float w0 = wp[0], w1 = wp[64], w2 = wp[128], w3 = wp[192];
#pragma unroll
                            for (int q = 0; q < 4; ++q) { const unsigned x = (unsigned)__builtin_amdgcn_readlane((int)hv[q].x, sl), y = (unsigned)__builtin_amdgcn_readlane((int)hv[q].y, sl);
                                a[q] += bf_lo(x) * w0 + bf_hi(x) * w1 + bf_lo(y) * w2 + bf_hi(y) * w3; } }
#pragma unroll
                        for (int q = 0; q < 4; ++q) { const int row = rowb + q * rst;
                            if (row < rlim) kcmp[((size_t)j * 8192 + row) * 64 + lane] = (bf16)f2bf((row & 127) == 127 ? 0.f : a[q]); } }
                }
            }
            LOCAL_BAR(); } TS(7);
        }
    }
#ifdef TIMING
    { PHASE(); FRESH_TID(); const unsigned tcs[8] = {tc0, tc1, tc2, tc3, tc4, tc5, tc6, tc7};
      float ta = (float)tcs[TIMING_A] * 0.01f, tb = (float)tcs[TIMING_B] * 0.01f;
      ta = __builtin_amdgcn_exp2f(__builtin_rintf(__log2f(fmaxf(ta, 1e-3f)) * 3.f + (TIMING_PHASE)) * (1.0f / 3.0f)); tb = __builtin_amdgcn_exp2f(__builtin_rintf(__log2f(fmaxf(tb, 1e-3f)) * 3.f + (TIMING_PHASE)) * (1.0f / 3.0f));
      const float c = __builtin_sqrtf(ta * (TIMING_SCALE));
      float* o = A0.out + zl; for (size_t i = (size_t)(bx * 512 + tid); i < (size_t)T * DM / 4; i += (size_t)G * 512) *(f32x4*)(o + i * 4) = (f32x4){c, c, c, c};
      __syncthreads(); if (bx == 0 && tid == 0) o[0] = tb; }
#endif
#ifdef DBG_DENOM
    { PHASE(); FRESH_TID(); const float v = __hip_atomic_load((float*)(WSL + WS_CTL) + 2048, RLX_AGENT) / (float)(DBG_DENOM);
      float E = 20.f + 4.f * __log2f(fmaxf(v, 1e-30f)); E = fminf(fmaxf(E, 1.f), 90.f); const float c = __builtin_sqrtf(E);
      float* o = A0.out + zl; for (size_t i = (size_t)(bx * 512 + tid); i < (size_t)T * DM / 4; i += (size_t)G * 512) *(f32x4*)(o + i * 4) = (f32x4){c, c, c, c}; }
#endif
#if NLAYERS < 4
    { PHASE(); FRESH_TID(); const bf16* hb = HB; float* o = A0.out + zl; for (size_t i = (size_t)(bx * 512 + tid); i < (size_t)T * DM / 4; i += (size_t)G * 512) { const v2u w = *(const v2u*)(hb + i * 4); *(f32x4*)(o + i * 4) = (f32x4){bf_lo(w.x), bf_hi(w.x), bf_lo(w.y), bf_hi(w.y)}; } }
#endif
}

extern "C" void kernel_launch(void* const* d_in, const int* in_sizes, int n_in, void* d_out, int out_size, void* d_ws, size_t ws_size, hipStream_t stream) {
    static int grid = 0;
    if (grid == 0) {
        if (n_in != 23 || in_sizes[0] != T * DM || out_size != T * DM || ws_size < WS_END) {
            fprintf(stderr, "kernel_launch: unexpected problem (n_in %d, in0 %d, out %d, ws %zu, need %zu); nothing launched\n", n_in, n_in > 0 ? in_sizes[0] : -1, out_size, ws_size, (size_t)WS_END); grid = -1; return; }
        int dev = 0, cus = 0, per_cu = 0;
        if (hipGetDevice(&dev) != hipSuccess || hipDeviceGetAttribute(&cus, hipDeviceAttributeMultiprocessorCount, dev) != hipSuccess) { grid = -1; return; }
        if (hipFuncSetAttribute((const void*)mega_fwd, hipFuncAttributeMaxDynamicSharedMemorySize, LDS_BYTES) != hipSuccess) { fprintf(stderr, "kernel_launch: hipFuncSetAttribute failed\n"); grid = -1; return; }
        if (hipOccupancyMaxActiveBlocksPerMultiprocessor(&per_cu, (const void*)mega_fwd, NWAVES * 64, LDS_BYTES) != hipSuccess || per_cu < 1) { fprintf(stderr, "kernel_launch: occupancy query says %d blocks per CU\n", per_cu); }
        (void)hipGetLastError();
        grid = cus;
    }
    if (grid < 0) return;
    if (hipMemsetAsync((char*)d_ws + WS_CTL, 0, CTL_ZERO_BYTES, stream) != hipSuccess) return;
    Args a{};
    a.x = (const float*)d_in[0]; a.ln_g = (const float*)d_in[1]; a.ln_b = (const float*)d_in[2]; a.lru_w_in = (const float*)d_in[3]; a.lru_conv_w = (const float*)d_in[4];
    a.lru_conv_b = (const float*)d_in[5]; a.lru_w_a = (const float*)d_in[6]; a.lru_b_a = (const float*)d_in[7]; a.lru_w_i = (const float*)d_in[8]; a.lru_b_i = (const float*)d_in[9];
    a.lru_lambda = (const float*)d_in[10]; a.lru_w_out = (const float*)d_in[11]; a.nsa_w_kv = (const float*)d_in[12]; a.nsa_cmp_pos = (const float*)d_in[13]; a.nsa_cmp_w1 = (const float*)d_in[14];
    a.nsa_cmp_w2 = (const float*)d_in[15]; a.nsa_w_qg = (const float*)d_in[16]; a.nsa_w_o = (const float*)d_in[17]; a.ffn_w_gu = (const float*)d_in[18]; a.ffn_w_down = (const float*)d_in[19];
    a.moe_w_router = (const float*)d_in[20]; a.moe_w_gu = (const float*)d_in[21]; a.moe_w_down = (const float*)d_in[22];
    a.out = (float*)d_out; a.ws = (unsigned char*)d_ws;
    hipLaunchKernelGGL(mega_fwd, dim3(grid), dim3(NWAVES * 64), LDS_BYTES, stream, a);
}
```
